# Optimizing an MI355X kernel written in HIP

```python
import jax, jax.numpy as jnp
from jax import lax
import numpy as np

D_MODEL = 1024
BATCH = 2
SEQ = 16384
DEPTH = 1
DEC_BATCH = 8
DEC_SEQ = 64
PAST_LEN = 1024

CHUNK = 64
HEAD_DIM = 64
WIN_HEADS = 8
WIN_KV_HEADS = 2
WINDOW = 128
WIN_CHUNKS = WINDOW // CHUNK
BAND_HEADS = 8
BAND_CHUNKS = 8
BAND = BAND_CHUNKS * CHUNK
REL_CLIP = 128
PLE_DIM = 256
ALIBI_MAX = 8.0
EPS = 1e-6
NEG_INF = -1e30

WIN_WIDTH = WIN_HEADS * HEAD_DIM
WIN_KV_WIDTH = WIN_KV_HEADS * HEAD_DIM
BAND_WIDTH = BAND_HEADS * HEAD_DIM
IN_SPLITS = (WIN_WIDTH, WIN_KV_WIDTH, WIN_KV_WIDTH, WIN_WIDTH,
             BAND_WIDTH, BAND_WIDTH, BAND_WIDTH, BAND_WIDTH, D_MODEL, D_MODEL)
IN_COLS = sum(IN_SPLITS)

kernel_name = "hybrid_streaming_encoder_step"


def rms_norm(x, g):
    xf = x.astype(jnp.float32)
    y = xf * lax.rsqrt(jnp.mean(xf * xf, axis=-1, keepdims=True) + EPS)
    return (y * g.astype(jnp.float32)).astype(x.dtype)


def project(h, g_in, w_in, g_q_win, g_k_win, g_q_band, g_k_band):
    B, S, _ = h.shape
    u = rms_norm(h, g_in) @ w_in
    cuts = np.cumsum(IN_SPLITS)[:-1].tolist()
    qa, ka, va, za, qb, kb, vb, zb, ga, gb = jnp.split(u, cuts, axis=-1)
    heads = lambda t, n: t.reshape(B, S, n, HEAD_DIM)
    qa = rms_norm(heads(qa, WIN_HEADS), g_q_win)
    ka = rms_norm(heads(ka, WIN_KV_HEADS), g_k_win)
    va = heads(va, WIN_KV_HEADS)
    qb = rms_norm(heads(qb, BAND_HEADS), g_q_band)
    kb = rms_norm(heads(kb, BAND_HEADS), g_k_band)
    vb = heads(vb, BAND_HEADS)
    return qa, ka, va, za, qb, kb, vb, zb, ga, gb


def rel_distance(past, cq, kn):
    return jnp.arange(cq)[:, None] + past - jnp.arange(kn)[None, :]


def alibi_bias(past, cq, kn):
    dist = jnp.abs(rel_distance(past, cq, kn)).astype(jnp.float32)
    slopes = jnp.exp2(-ALIBI_MAX * jnp.arange(1, WIN_HEADS + 1, dtype=jnp.float32) / WIN_HEADS)
    return -slopes[:, None, None] * dist[None]


def rel_pos_bias(table, past, cq, kn):
    idx = jnp.clip(rel_distance(past, cq, kn), -REL_CLIP, REL_CLIP) + REL_CLIP
    return table.astype(jnp.float32)[:, idx]


def band_attention(q, k, v, bias, valid, sink):
    B, nC, Cq, H, dh = q.shape
    Kn, Hkv = k.shape[2], k.shape[3]
    G = H // Hkv
    qg = q.reshape(B, nC, Cq, Hkv, G, dh)
    s = jnp.einsum('bnqhgd,bnkhd->bnhgqk', qg, k, preferred_element_type=jnp.float32) * (dh ** -0.5)
    s = s + bias.reshape(Hkv, G, Cq, Kn)
    if valid is not None:
        s = jnp.where(valid[None, :, None, None, None, :], s, NEG_INF)
    if sink is not None:
        sk = sink.astype(jnp.float32).reshape(1, 1, Hkv, G, 1, 1)
        m = jnp.maximum(jnp.max(s, axis=-1, keepdims=True), sk)
        e = jnp.exp(s - m)
        pr = e / (jnp.sum(e, axis=-1, keepdims=True) + jnp.exp(sk - m))
    else:
        pr = jax.nn.softmax(s, axis=-1)
    o = jnp.einsum('bnhgqk,bnkhd->bnqhgd', pr.astype(v.dtype), v)
    return o.reshape(B, nC, Cq, H * dh)


def chunk_band(t, nb):
    B, S, Hk, dh = t.shape
    nC = S // CHUNK
    tp = jnp.pad(t.reshape(B, nC, CHUNK, Hk, dh), ((0, 0), (nb, 0), (0, 0), (0, 0), (0, 0)))
    return jnp.concatenate([tp[:, j:j + nC] for j in range(nb + 1)], axis=2)


def band_valid(nC, nb):
    ci = jnp.arange(nC)[:, None] - nb + jnp.arange(nb + 1)[None, :]
    return jnp.repeat(ci >= 0, CHUNK, axis=1)


def merge_and_finish(h, oa, ob, za, zb, ga, gb, p, w_o_win, w_o_band, w_out, g_ple, w_ple_gate, w_ple):
    branch_a = (oa * jax.nn.silu(za)) @ w_o_win
    branch_b = (ob * jax.nn.silu(zb)) @ w_o_band
    h = h + (jax.nn.sigmoid(ga) * branch_a + jax.nn.sigmoid(gb) * branch_b) @ w_out
    gate = jax.nn.sigmoid(rms_norm(h, g_ple) @ w_ple_gate)
    return h + gate * (p @ w_ple)


def prompt_layer(h, p, lw):
    (g_in, w_in, g_q_win, g_k_win, sink_win, g_q_band, g_k_band, rel_bias_band,
     w_o_win, w_o_band, w_out, g_ple, w_ple_gate, w_ple) = lw
    B, S, _ = h.shape
    nC = S // CHUNK
    qa, ka, va, za, qb, kb, vb, zb, ga, gb = project(h, g_in, w_in, g_q_win, g_k_win, g_q_band, g_k_band)
    kn_a = (WIN_CHUNKS + 1) * CHUNK
    oa = band_attention(qa.reshape(B, nC, CHUNK, WIN_HEADS, HEAD_DIM),
                        chunk_band(ka, WIN_CHUNKS), chunk_band(va, WIN_CHUNKS),
                        alibi_bias(WIN_CHUNKS * CHUNK, CHUNK, kn_a),
                        band_valid(nC, WIN_CHUNKS), sink_win).reshape(B, S, WIN_WIDTH)
    kn_b = (BAND_CHUNKS + 1) * CHUNK
    ob = band_attention(qb.reshape(B, nC, CHUNK, BAND_HEADS, HEAD_DIM),
                        chunk_band(kb, BAND_CHUNKS), chunk_band(vb, BAND_CHUNKS),
                        rel_pos_bias(rel_bias_band, BAND_CHUNKS * CHUNK, CHUNK, kn_b),
                        band_valid(nC, BAND_CHUNKS), None).reshape(B, S, BAND_WIDTH)
    out = merge_and_finish(h, oa, ob, za, zb, ga, gb, p, w_o_win, w_o_band, w_out, g_ple, w_ple_gate, w_ple)
    la, lb = min(WINDOW, S), min(BAND, S)
    return out, ka[:, S - la:], va[:, S - la:], kb[:, S - lb:], vb[:, S - lb:]


def sample_layer(h, p, ck_win, cv_win, ck_band, cv_band, lw):
    (g_in, w_in, g_q_win, g_k_win, sink_win, g_q_band, g_k_band, rel_bias_band,
     w_o_win, w_o_band, w_out, g_ple, w_ple_gate, w_ple) = lw
    B, S, _ = h.shape
    qa, ka, va, za, qb, kb, vb, zb, ga, gb = project(h, g_in, w_in, g_q_win, g_k_win, g_q_band, g_k_band)
    ka_all = jnp.concatenate([ck_win, ka], axis=1)
    va_all = jnp.concatenate([cv_win, va], axis=1)
    kb_all = jnp.concatenate([ck_band, kb], axis=1)
    vb_all = jnp.concatenate([cv_band, vb], axis=1)
    la, lb = ck_win.shape[1], ck_band.shape[1]
    oa = band_attention(qa[:, None], ka_all[:, None], va_all[:, None],
                        alibi_bias(la, S, la + S), None, sink_win)[:, 0]
    ob = band_attention(qb[:, None], kb_all[:, None], vb_all[:, None],
                        rel_pos_bias(rel_bias_band, lb, S, lb + S), None, None)[:, 0]
    out = merge_and_finish(h, oa, ob, za, zb, ga, gb, p, w_o_win, w_o_band, w_out, g_ple, w_ple_gate, w_ple)
    na, nb = ka_all.shape[1], kb_all.shape[1]
    ra, rb = min(WINDOW, na), min(BAND, nb)
    return out, ka_all[:, na - ra:], va_all[:, na - ra:], kb_all[:, nb - rb:], vb_all[:, nb - rb:]


def setup_inputs(seed: int = 0) -> dict:
    key = jax.random.key(seed)
    ks = jax.random.split(key, 22)
    nrm = lambda k, shape, s=1.0: s * jax.random.normal(k, shape, jnp.float32)
    la, lb = min(WINDOW, PAST_LEN), min(BAND, PAST_LEN)
    return {
        "x_prompt": nrm(ks[0], (BATCH, SEQ, D_MODEL)),
        "x_sample": nrm(ks[1], (DEC_BATCH, DEC_SEQ, D_MODEL)),
        "cache_k_win": nrm(ks[2], (DEPTH, DEC_BATCH, la, WIN_KV_HEADS, HEAD_DIM)),
        "cache_v_win": nrm(ks[3], (DEPTH, DEC_BATCH, la, WIN_KV_HEADS, HEAD_DIM)),
        "cache_k_band": nrm(ks[4], (DEPTH, DEC_BATCH, lb, BAND_HEADS, HEAD_DIM)),
        "cache_v_band": nrm(ks[5], (DEPTH, DEC_BATCH, lb, BAND_HEADS, HEAD_DIM)),
        "p_prompt": nrm(ks[6], (DEPTH, BATCH, SEQ, PLE_DIM)),
        "p_sample": nrm(ks[7], (DEPTH, DEC_BATCH, DEC_SEQ, PLE_DIM)),
        "g_in": 1.0 + nrm(ks[8], (DEPTH, D_MODEL), 0.05),
        "w_in": nrm(ks[9], (DEPTH, D_MODEL, IN_COLS), D_MODEL ** -0.5),
        "g_q_win": 1.0 + nrm(ks[10], (DEPTH, HEAD_DIM), 0.05),
        "g_k_win": 1.0 + nrm(ks[11], (DEPTH, HEAD_DIM), 0.05),
        "sink_win": nrm(ks[12], (DEPTH, WIN_HEADS), 0.5),
        "g_q_band": 1.0 + nrm(ks[13], (DEPTH, HEAD_DIM), 0.05),
        "g_k_band": 1.0 + nrm(ks[14], (DEPTH, HEAD_DIM), 0.05),
        "rel_bias_band": nrm(ks[15], (DEPTH, BAND_HEADS, 2 * REL_CLIP + 1), 0.1),
        "w_o_win": nrm(ks[16], (DEPTH, WIN_WIDTH, D_MODEL), WIN_WIDTH ** -0.5),
        "w_o_band": nrm(ks[17], (DEPTH, BAND_WIDTH, D_MODEL), BAND_WIDTH ** -0.5),
        "w_out": nrm(ks[18], (DEPTH, D_MODEL, D_MODEL), D_MODEL ** -0.5),
        "g_ple": 1.0 + nrm(ks[19], (DEPTH, D_MODEL), 0.05),
        "w_ple_gate": nrm(ks[20], (DEPTH, D_MODEL, D_MODEL), D_MODEL ** -0.5),
        "w_ple": nrm(ks[21], (DEPTH, PLE_DIM, D_MODEL), PLE_DIM ** -0.5),
    }


def reference(x_prompt, x_sample, cache_k_win, cache_v_win, cache_k_band, cache_v_band,
              p_prompt, p_sample, g_in, w_in, g_q_win, g_k_win, sink_win, g_q_band, g_k_band,
              rel_bias_band, w_o_win, w_o_band, w_out, g_ple, w_ple_gate, w_ple):
    h_p, h_s = x_prompt, x_sample
    kwp, vwp, kbp, vbp, kws, vws, kbs, vbs = [], [], [], [], [], [], [], []
    for i in range(DEPTH):
        lw = (g_in[i], w_in[i], g_q_win[i], g_k_win[i], sink_win[i], g_q_band[i], g_k_band[i],
              rel_bias_band[i], w_o_win[i], w_o_band[i], w_out[i], g_ple[i], w_ple_gate[i], w_ple[i])
        h_p, a, b, c, d = prompt_layer(h_p, p_prompt[i], lw)
        kwp.append(a); vwp.append(b); kbp.append(c); vbp.append(d)
        h_s, a, b, c, d = sample_layer(h_s, p_sample[i], cache_k_win[i], cache_v_win[i],
                                       cache_k_band[i], cache_v_band[i], lw)
        kws.append(a); vws.append(b); kbs.append(c); vbs.append(d)
    return (h_p, h_s,
            jnp.stack(kwp), jnp.stack(vwp), jnp.stack(kbp), jnp.stack(vbp),
            jnp.stack(kws), jnp.stack(vws), jnp.stack(kbs), jnp.stack(vbs))
```

```cpp
#include <hip/hip_runtime.h>
#include <hip/hip_cooperative_groups.h>
#include <cstdio>
#include <cstdint>
namespace cg = cooperative_groups;
#ifndef PROBE_MODE
#define PROBE_MODE 0
#endif

#define LAS __attribute__((address_space(3)))
#define GAS __attribute__((address_space(1)))
typedef unsigned short bf16_t;
typedef short bf16x8 __attribute__((ext_vector_type(8)));
typedef short s16x4 __attribute__((ext_vector_type(4)));
typedef float f32x4 __attribute__((ext_vector_type(4)));
typedef float f32x16 __attribute__((ext_vector_type(16)));
typedef unsigned u32x4 __attribute__((ext_vector_type(4)));
typedef unsigned u32x2 __attribute__((ext_vector_type(2)));

constexpr int MP = 32768, MS = 512, M = MP + MS;
constexpr int DM = 1024, NIN = 5376, LDU = NIN;
constexpr int CACHE_ROW0 = M;
constexpr int UROWS = M + 8 * 512;
constexpr int LDHP = 1280;
constexpr float EPS = 1e-6f;
constexpr float LOG2E = 1.4426950408889634f;
constexpr float ATT_THR = 8.f;
constexpr float C2 = 0.125f * LOG2E;
constexpr size_t O_Y = 0, O_KWP = 34078720, O_VWP = 34111488, O_KBP = 34144256, O_VBP = 34668544,
                 O_KWS = 35192832, O_VWS = 35323904, O_KBS = 35454976, O_VBS = 37552128, O_END = 39649280;
constexpr int C_QA = 0, C_KA = 512, C_VA = 640, C_ZA = 768, C_QB = 1280, C_KB = 1792, C_VB = 2304, C_ZB = 2816, C_GA = 3328, C_GB = 4352;

constexpr size_t MiB = 1u << 20;
constexpr size_t WS_GT = 1 * MiB;
constexpr size_t WS_WIN = 2 * MiB;
constexpr size_t WS_WO = 13 * MiB;
constexpr size_t WS_WOUT = 15 * MiB;
constexpr size_t WS_WGP = 17 * MiB;
constexpr size_t WS_SS = 20 * MiB;
constexpr size_t WS_R1 = 24 * MiB;
constexpr size_t WS_U = 90 * MiB;
constexpr size_t WS_END = WS_U + (size_t)UROWS * LDU * 2;
static_assert(WS_END <= 512 * MiB, "d_ws map");

typedef float f32x2_t __attribute__((ext_vector_type(2))); typedef __bf16 bf16x2_t __attribute__((ext_vector_type(2)));
__device__ __forceinline__ unsigned cvt_pk_bf16(float lo, float hi) { const f32x2_t v = {lo, hi}; const bf16x2_t b = __builtin_convertvector(v, bf16x2_t); return __builtin_bit_cast(unsigned, b); }
__device__ __forceinline__ float bf_lo(unsigned w) { return __uint_as_float(w << 16); }
__device__ __forceinline__ float bf_hi(unsigned w) { return __uint_as_float(w & 0xffff0000u); }
__device__ __forceinline__ float fast_exp2(float x) { return __builtin_amdgcn_exp2f(x); }
__device__ __forceinline__ float fast_rcp(float x) { return __builtin_amdgcn_rcpf(x); }
__device__ __forceinline__ float sigmoidf_(float x) { return fast_rcp(1.f + fast_exp2(-LOG2E * x)); }
__device__ __forceinline__ float wave_sum(float v) {
#pragma unroll
    for (int o = 1; o < 64; o <<= 1) v += __shfl_xor(v, o);
    return v;
}

namespace pg8 {
constexpr int BM = 256, BK = 64, HALF = 128, HTB = HALF * BK * 2, STAGE_BYTES = 8 * HTB, NXCD = 8, WGM = 8;
__host__ __device__ __forceinline__ int lds_byte(int r, int c) { const int st = (r >> 4) * 2 + (c >> 5), rr = r & 15, cc = c & 31, ob = rr * 64 + cc * 2; return st * 1024 + (ob ^ (((ob >> 9) & 1) << 5)); }
__host__ __device__ __forceinline__ void stage_rc(int b, int& R, int& C) { const int st = b / 1024, sb = b % 1024, swz = sb ^ (((sb >> 9) & 1) << 5); R = (st >> 1) * 16 + swz / 64; C = (st & 1) * 32 + (swz % 64) / 2; }
__host__ __device__ __forceinline__ int perm32(int rho) { const int n = rho >> 4, i = rho & 15; return 8 * (i >> 2) + 4 * n + (i & 3); }

struct Unit { int pm, pn, seg, ti; };
struct Gemm { const bf16_t* A; const bf16_t* Bt; int lda, ldb; };

struct StaticOrder {
    int nM, nN, nwg, G, c, nseg;
    __device__ void init(int M_, int N_, int G_, int c_, int nseg_) { nM = M_ / BM; nN = N_ / BM; nwg = nM * nN; G = G_; c = c_; nseg = nseg_; }
    __device__ bool next(int i, Unit& u) const {
        const int it = (nseg == 2) ? (i >> 1) : i;
        const long L = (long)it * G + c; if (L >= nwg) return false;
        int wgid = (int)L; { const int q = nwg / NXCD, r = nwg % NXCD, xcd = wgid % NXCD, off = wgid / NXCD; wgid = (xcd < r ? xcd * (q + 1) : r * (q + 1) + (xcd - r) * q) + off; }
        const int nig = WGM * nN, gid = wgid / nig, fm = gid * WGM, gsz = (nM - fm) < WGM ? (nM - fm) : WGM;
        u.pm = fm + ((wgid % nig) % gsz); u.pn = (wgid % nig) / gsz; u.seg = (nseg == 2) ? (i & 1) : 0; u.ti = it; return true;
    }
};

template <class Epi, int AC0, int BC0, int NT0, int AC1, int BC1, int NT1>
__device__ __forceinline__ void gemm_phase(LAS unsigned char* lds, const Gemm g, const StaticOrder& S, const Epi& E, int tid) {
    const int wid = __builtin_amdgcn_readfirstlane(tid >> 6), lane = tid & 63, wr = wid >> 2, wc = wid & 3, fr = lane & 15, fq = lane >> 4;
    unsigned voffA[2], voffB[2];
#pragma unroll
    for (int i = 0; i < 2; ++i) { int R, C; stage_rc(tid * 16 + i * 8192, R, C); const int Rb = (R & ~31) + perm32(R & 31);
        voffA[i] = (unsigned)(R * g.lda + C) * 2u; voffB[i] = (unsigned)(Rb * g.ldb + C) * 2u; }
    const size_t kstep = (size_t)(BK * 2);
    const size_t hstepA = (size_t)HALF * g.lda * 2, hstepB = (size_t)HALF * g.ldb * 2;
    const unsigned ldsw = (unsigned)wid * 1024u;
    const int aoff = lds_byte(wr * 64 + fr, fq * 8), boff = lds_byte(wc * 32 + fr, fq * 8);
#define PG8_SA(b, h) (((b) * 2 + (h)) * HTB)
#define PG8_SB(b, h) ((4 + (b) * 2 + (h)) * HTB)
#define PG8_STAGE(bufoff, gbase, voff) do { _Pragma("unroll") for (int _i = 0; _i < 2; ++_i) \
        __builtin_amdgcn_global_load_lds((const unsigned*)((const char*)(gbase) + (voff)[_i]), (LAS unsigned*)(lds + (bufoff) + ldsw + _i * 8192), 16, 0, 0); } while (0)
#define PG8_LDA(dst, b, h) do { _Pragma("unroll") for (int m = 0; m < 4; ++m) _Pragma("unroll") for (int k = 0; k < 2; ++k) dst[m][k] = *(const LAS bf16x8*)(lds + PG8_SA(b, h) + aoff + m * 2048 + k * 1024); } while (0)
#define PG8_LDB(dst, b, h) do { _Pragma("unroll") for (int n = 0; n < 2; ++n) _Pragma("unroll") for (int k = 0; k < 2; ++k) dst[n][k] = *(const LAS bf16x8*)(lds + PG8_SB(b, h) + boff + n * 2048 + k * 1024); } while (0)
#define PG8_MMA(ai, bj, At, Bt) do { __builtin_amdgcn_s_setprio(1); _Pragma("unroll") for (int m = 0; m < 4; ++m) _Pragma("unroll") for (int n = 0; n < 2; ++n) _Pragma("unroll") for (int k = 0; k < 2; ++k) \
        acc[ai][bj][m][n] = __builtin_amdgcn_mfma_f32_16x16x32_bf16(Bt[n][k], At[m][k], acc[ai][bj][m][n], 0, 0, 0); __builtin_amdgcn_s_setprio(0); } while (0)
#define PG8_WAIT_V(n) asm volatile("s_waitcnt vmcnt(" #n ")" ::: "memory")
#define PG8_WAIT_L(n) asm volatile("s_waitcnt lgkmcnt(" #n ")" ::: "memory")
#define PG8_BAR __builtin_amdgcn_s_barrier()
#define PG8_SCHED __builtin_amdgcn_sched_barrier(0)
#define PG8_APTR(u) ((const char*)g.A + ((size_t)(u).pm * 2 * hstepA + (size_t)(AC0 + (u).seg * (AC1 - AC0)) * 2))
#define PG8_BPTR(u) ((const char*)g.Bt + ((size_t)(u).pn * 2 * hstepB + (size_t)(BC0 + (u).seg * (BC1 - BC0)) * 2))
    Unit cur, nxt; int ui = 0;
    if (!S.next(0, cur)) return;
    f32x4 acc[2][2][4][2];
#pragma unroll
    for (int a = 0; a < 2; ++a)
#pragma unroll
        for (int b = 0; b < 2; ++b)
#pragma unroll
            for (int m = 0; m < 4; ++m)
#pragma unroll
                for (int n = 0; n < 2; ++n) acc[a][b][m][n] = (f32x4){0.f, 0.f, 0.f, 0.f};
    bf16x8 At[4][2], B0[2][2], B1[2][2];
    const char* cA = PG8_APTR(cur); const char* cB = PG8_BPTR(cur);
    PG8_STAGE(PG8_SB(0, 0), cB, voffB); PG8_STAGE(PG8_SB(0, 1), cB + hstepB, voffB); PG8_STAGE(PG8_SA(0, 0), cA, voffA); PG8_STAGE(PG8_SA(0, 1), cA + hstepA, voffA);
    if (wr == 1) PG8_BAR;
    PG8_WAIT_V(2); PG8_BAR;
    PG8_STAGE(PG8_SB(1, 0), cB + kstep, voffB); PG8_STAGE(PG8_SA(1, 0), cA + kstep, voffA); PG8_STAGE(PG8_SB(1, 1), cB + hstepB + kstep, voffB);
    PG8_WAIT_V(6); PG8_BAR;
    for (;;) {
        const bool has_next = S.next(ui + 1, nxt);
        const char* nA = has_next ? PG8_APTR(nxt) : cA; const char* nB = has_next ? PG8_BPTR(nxt) : cB;
        const int nt = NT0 + cur.seg * (NT1 - NT0);
        for (int t = 0; t < nt; t += 2) {
            const bool last = (t == nt - 2);
            const char* a1 = cA + (size_t)(t + 1) * kstep;
            const char* a2 = last ? nA : cA + (size_t)(t + 2) * kstep; const char* b2 = last ? nB : cB + (size_t)(t + 2) * kstep;
            const char* a3 = a2 + kstep; const char* b3 = b2 + kstep;
            PG8_LDB(B0, 0, 0); PG8_LDB(B1, 0, 1); PG8_SCHED; PG8_LDA(At, 0, 0); PG8_STAGE(PG8_SA(1, 1), a1 + hstepA, voffA);
            PG8_WAIT_V(8); PG8_WAIT_L(0); PG8_BAR; PG8_MMA(0, 0, At, B0); PG8_MMA(0, 1, At, B1); PG8_BAR; PG8_SCHED;
            PG8_LDA(At, 0, 1); PG8_STAGE(PG8_SB(0, 0), b2, voffB); PG8_STAGE(PG8_SB(0, 1), b2 + hstepB, voffB); PG8_STAGE(PG8_SA(0, 0), a2, voffA);
            PG8_WAIT_V(8); PG8_WAIT_L(0); PG8_BAR; PG8_MMA(1, 0, At, B0); PG8_MMA(1, 1, At, B1); PG8_BAR; PG8_SCHED;
            PG8_LDB(B0, 1, 0); PG8_LDB(B1, 1, 1); PG8_SCHED; PG8_LDA(At, 1, 0); PG8_STAGE(PG8_SA(0, 1), a2 + hstepA, voffA);
            PG8_WAIT_V(8); PG8_WAIT_L(0); PG8_BAR; PG8_MMA(0, 0, At, B0); PG8_MMA(0, 1, At, B1); PG8_BAR; PG8_SCHED;
            PG8_LDA(At, 1, 1); PG8_STAGE(PG8_SB(1, 0), b3, voffB); PG8_STAGE(PG8_SB(1, 1), b3 + hstepB, voffB); PG8_STAGE(PG8_SA(1, 0), a3, voffA);
            PG8_WAIT_V(8); PG8_WAIT_L(0); PG8_BAR; PG8_MMA(1, 0, At, B0); PG8_MMA(1, 1, At, B1); PG8_BAR; PG8_SCHED;
        }
        if (wr == 0) PG8_BAR;
        E(acc, cur, wr, wc, fr, fq);
        if (!has_next) break;
        if (!(Epi::KEEP0 && cur.seg == 0)) {
#pragma unroll
            for (int a = 0; a < 2; ++a)
#pragma unroll
                for (int b = 0; b < 2; ++b)
#pragma unroll
                    for (int m = 0; m < 4; ++m)
#pragma unroll
                        for (int n = 0; n < 2; ++n) acc[a][b][m][n] = (f32x4){0.f, 0.f, 0.f, 0.f};
        }
        cur = nxt; cA = nA; cB = nB; ++ui;
        if (wr == 1) PG8_BAR;
    }
    PG8_WAIT_V(0);
    PG8_BAR;
#undef PG8_SA
#undef PG8_SB
#undef PG8_STAGE
#undef PG8_LDA
#undef PG8_LDB
#undef PG8_MMA
#undef PG8_WAIT_V
#undef PG8_WAIT_L
#undef PG8_BAR
#undef PG8_SCHED
#undef PG8_APTR
#undef PG8_BPTR
}

#define EPI_ROWS(ai, m) (u.pm * BM + (ai) * HALF + wr * 64 + (m) * 16 + fr)

struct EpiIn {
    static constexpr bool KEEP0 = false;
    bf16_t* U; float* out; const float* GT;
    __device__ __forceinline__ void operator()(f32x4 (&acc)[2][2][4][2], const Unit& u, int wr, int wc, int fr, int fq) const {
        const int g64 = u.pn * 4 + wc;
        const bool is_q = (g64 < 8) || (g64 >= 20 && g64 < 28);
        const bool is_k = (g64 >= 8 && g64 < 10) || (g64 >= 28 && g64 < 36);
        const bool is_norm = is_q || is_k;
        const bool is_silu = (g64 >= 12 && g64 < 20) || (g64 >= 44 && g64 < 52);
        const bool is_sig = g64 >= 52;
        const float* gp = GT + 64 * (g64 < 8 ? 0 : (g64 < 10 ? 1 : (g64 < 28 ? 2 : 3)));
        const float post = is_q ? C2 : 1.f;
        const bool kv_win = (g64 >= 8 && g64 < 12), kv_band = (g64 >= 28 && g64 < 44);
        const bool tile_has_out = (u.pm == 62 || u.pm == 63 || u.pm == 126 || u.pm == 127 || u.pm >= 128);
        f32x4 gv[2][2];
#pragma unroll
        for (int bj = 0; bj < 2; ++bj)
#pragma unroll
            for (int n = 0; n < 2; ++n) gv[bj][n] = is_norm ? *(const f32x4*)(gp + 32 * bj + 8 * fq + 4 * n) : (f32x4){1.f, 1.f, 1.f, 1.f};
#pragma unroll
        for (int ai = 0; ai < 2; ++ai)
#pragma unroll
            for (int m = 0; m < 4; ++m) {
                const int r = EPI_ROWS(ai, m);
                f32x4 v[2][2];
#pragma unroll
                for (int bj = 0; bj < 2; ++bj)
#pragma unroll
                    for (int n = 0; n < 2; ++n) v[bj][n] = acc[ai][bj][m][n];
                if (is_norm) {
                    float ss = 0.f;
#pragma unroll
                    for (int bj = 0; bj < 2; ++bj)
#pragma unroll
                        for (int n = 0; n < 2; ++n) { const f32x4 x = v[bj][n]; ss += (x[0] * x[0] + x[1] * x[1]) + (x[2] * x[2] + x[3] * x[3]); }
                    ss += __shfl_xor(ss, 16); ss += __shfl_xor(ss, 32);
                    const float rs = rsqrtf(ss * (1.f / 64.f) + EPS);
#pragma unroll
                    for (int bj = 0; bj < 2; ++bj)
#pragma unroll
                        for (int n = 0; n < 2; ++n) v[bj][n] = v[bj][n] * rs * gv[bj][n];
                } else if (is_silu) {
#pragma unroll
                    for (int bj = 0; bj < 2; ++bj)
#pragma unroll
                        for (int n = 0; n < 2; ++n)
#pragma unroll
                            for (int j = 0; j < 4; ++j) v[bj][n][j] = v[bj][n][j] * sigmoidf_(v[bj][n][j]);
                } else if (is_sig) {
#pragma unroll
                    for (int bj = 0; bj < 2; ++bj)
#pragma unroll
                        for (int n = 0; n < 2; ++n)
#pragma unroll
                            for (int j = 0; j < 4; ++j) v[bj][n][j] = fast_rcp(1.f + fast_exp2(v[bj][n][j]));
                }
                if (tile_has_out && (kv_win || kv_band)) {
                    long dst = -1;
                    if (kv_win) {
                        const int hk = (g64 - 8) & 1; const bool isv = g64 >= 10;
                        if (r < MP) { const int b = r >> 14, t = r & 16383; if (t >= 16256) dst = (long)(isv ? O_VWP : O_KWP) + ((long)(b * 128 + (t - 16256)) * 2 + hk) * 64; }
                        else { const int b = (r - MP) >> 6, i = (r - MP) & 63; dst = (long)(isv ? O_VWS : O_KWS) + ((long)(b * 128 + 64 + i) * 2 + hk) * 64; }
                    } else {
                        const int h = (g64 - 28) & 7; const bool isv = g64 >= 36;
                        if (r < MP) { const int b = r >> 14, t = r & 16383; if (t >= 15872) dst = (long)(isv ? O_VBP : O_KBP) + ((long)(b * 512 + (t - 15872)) * 8 + h) * 64; }
                        else { const int b = (r - MP) >> 6, i = (r - MP) & 63; dst = (long)(isv ? O_VBS : O_KBS) + ((long)(b * 512 + 448 + i) * 8 + h) * 64; }
                    }
                    if (dst >= 0) {
#pragma unroll
                        for (int bj = 0; bj < 2; ++bj)
#pragma unroll
                            for (int n = 0; n < 2; ++n) __builtin_nontemporal_store(v[bj][n], (f32x4*)(out + dst + 32 * bj + 8 * fq + 4 * n));
                    }
                }
                bf16_t* rowp = U + (size_t)r * LDU + g64 * 64 + 8 * fq;
#pragma unroll
                for (int bj = 0; bj < 2; ++bj) {
                    f32x4 v0 = v[bj][0], v1 = v[bj][1]; if (is_q) { v0 = v0 * post; v1 = v1 * post; }
                    u32x4 w; w.x = cvt_pk_bf16(v0[0], v0[1]); w.y = cvt_pk_bf16(v0[2], v0[3]); w.z = cvt_pk_bf16(v1[0], v1[1]); w.w = cvt_pk_bf16(v1[2], v1[3]);
                    __builtin_nontemporal_store(w, (u32x4*)(rowp + 32 * bj));
                }
            }
    }
};

struct EpiBranch {
    static constexpr bool KEEP0 = true;
    const bf16_t* U; bf16_t* Mg;
    __device__ __forceinline__ void operator()(f32x4 (&acc)[2][2][4][2], const Unit& u, int wr, int wc, int fr, int fq) const {
        const int c0 = u.pn * BM + wc * 64 + 8 * fq;
#pragma unroll
        for (int ai = 0; ai < 2; ++ai) {
            u32x4 gb[4][2], ga[4][2];
#pragma unroll
            for (int m = 0; m < 4; ++m) { const bf16_t* urow = U + (size_t)EPI_ROWS(ai, m) * LDU;
#pragma unroll
                for (int bj = 0; bj < 2; ++bj) { gb[m][bj] = *(const u32x4*)(urow + C_GB + c0 + 32 * bj); if (u.seg == 0) ga[m][bj] = *(const u32x4*)(urow + C_GA + c0 + 32 * bj); } }
            asm volatile("" ::: "memory");
#pragma unroll
            for (int m = 0; m < 4; ++m) {
                const int r = EPI_ROWS(ai, m);
#pragma unroll
                for (int bj = 0; bj < 2; ++bj) {
                    if (u.seg == 0) {
#pragma unroll
                        for (int q = 0; q < 4; ++q) {
                            const float r0 = bf_lo(ga[m][bj][q]) * fast_rcp(bf_lo(gb[m][bj][q])), r1 = bf_hi(ga[m][bj][q]) * fast_rcp(bf_hi(gb[m][bj][q]));
                            acc[ai][bj][m][q >> 1][(q & 1) * 2] *= r0; acc[ai][bj][m][q >> 1][(q & 1) * 2 + 1] *= r1;
                        }
                    } else {
                        u32x4 w;
#pragma unroll
                        for (int q = 0; q < 4; ++q) {
                            const float a0 = acc[ai][bj][m][q >> 1][(q & 1) * 2] * bf_lo(gb[m][bj][q]), a1 = acc[ai][bj][m][q >> 1][(q & 1) * 2 + 1] * bf_hi(gb[m][bj][q]);
                            w[q] = cvt_pk_bf16(a0, a1);
                        }
                        *(u32x4*)(Mg + (size_t)r * DM + c0 + 32 * bj) = w;
                    }
                }
            }
            asm volatile("" ::: "memory");
        }
    }
};

struct EpiOut {
    static constexpr bool KEEP0 = false;
    const float* xp; const float* xs; bf16_t* HP; float* SS;
    __device__ __forceinline__ void operator()(f32x4 (&acc)[2][2][4][2], const Unit& u, int wr, int wc, int fr, int fq) const {
        const int c0 = u.pn * BM + wc * 64 + 8 * fq;
        const float* xb = (u.pm < MP / BM) ? xp : (xs - (size_t)MP * DM);
#pragma unroll
        for (int ai = 0; ai < 2; ++ai) {
            f32x4 xv[4][2][2];
#pragma unroll
            for (int m = 0; m < 4; ++m) { const float* xrow = xb + (size_t)EPI_ROWS(ai, m) * DM + c0;
#pragma unroll
                for (int bj = 0; bj < 2; ++bj) { xv[m][bj][0] = __builtin_nontemporal_load((const f32x4*)(xrow + 32 * bj)); xv[m][bj][1] = __builtin_nontemporal_load((const f32x4*)(xrow + 32 * bj + 4)); } }
            asm volatile("" ::: "memory");
#pragma unroll
            for (int m = 0; m < 4; ++m) {
                const int r = EPI_ROWS(ai, m);
                float ss = 0.f;
#pragma unroll
                for (int bj = 0; bj < 2; ++bj) {
                    const f32x4 h0 = acc[ai][bj][m][0] + xv[m][bj][0], h1 = acc[ai][bj][m][1] + xv[m][bj][1];
                    ss += (h0[0] * h0[0] + h0[1] * h0[1]) + (h0[2] * h0[2] + h0[3] * h0[3]) + (h1[0] * h1[0] + h1[1] * h1[1]) + (h1[2] * h1[2] + h1[3] * h1[3]);
                    u32x4 w; w.x = cvt_pk_bf16(h0[0], h0[1]); w.y = cvt_pk_bf16(h0[2], h0[3]); w.z = cvt_pk_bf16(h1[0], h1[1]); w.w = cvt_pk_bf16(h1[2], h1[3]);
                    *(u32x4*)(HP + (size_t)r * LDHP + c0 + 32 * bj) = w;
                }
                ss += __shfl_xor(ss, 16); ss += __shfl_xor(ss, 32);
                if (fq == 0) SS[(size_t)r * 16 + u.pn * 4 + wc] = ss;
            }
            asm volatile("" ::: "memory");
        }
    }
};

struct EpiFinal {
    static constexpr bool KEEP0 = false;
    float* out; bf16_t* PLE; const float* SS; const bf16_t* HP; const LAS float* rs;
    __device__ __forceinline__ void operator()(f32x4 (&acc)[2][2][4][2], const Unit& u, int wr, int wc, int fr, int fq) const {
        const int c0 = u.pn * BM + wc * 64 + 8 * fq;
        if (u.seg == 0) {
#pragma unroll
            for (int ai = 0; ai < 2; ++ai)
#pragma unroll
                for (int m = 0; m < 4; ++m) {
                    bf16_t* prow = PLE + (size_t)EPI_ROWS(ai, m) * DM + c0;
#pragma unroll
                    for (int bj = 0; bj < 2; ++bj) {
                        const f32x4 v0 = acc[ai][bj][m][0], v1 = acc[ai][bj][m][1];
                        u32x4 w; w.x = cvt_pk_bf16(v0[0], v0[1]); w.y = cvt_pk_bf16(v0[2], v0[3]); w.z = cvt_pk_bf16(v1[0], v1[1]); w.w = cvt_pk_bf16(v1[2], v1[3]);
                        *(u32x4*)(prow + 32 * bj) = w;
                    }
                }
            return;
        }
#pragma unroll
        for (int ai = 0; ai < 2; ++ai) {
            u32x4 pw[4][2], hw[4][2]; float rstd[4];
#pragma unroll
            for (int m = 0; m < 4; ++m) { const int r = EPI_ROWS(ai, m);
#pragma unroll
                for (int bj = 0; bj < 2; ++bj) { pw[m][bj] = *(const u32x4*)(PLE + (size_t)r * DM + c0 + 32 * bj); hw[m][bj] = *(const u32x4*)(HP + (size_t)r * LDHP + c0 + 32 * bj); }
                if (rs) rstd[m] = rs[u.ti * 256 + ai * HALF + wr * 64 + m * 16 + fr];
                else { const f32x4* sp = (const f32x4*)(SS + (size_t)r * 16); const f32x4 s0 = sp[0], s1 = sp[1], s2 = sp[2], s3 = sp[3];
                    const float st = ((s0[0] + s0[1]) + (s0[2] + s0[3])) + ((s1[0] + s1[1]) + (s1[2] + s1[3])) + ((s2[0] + s2[1]) + (s2[2] + s2[3])) + ((s3[0] + s3[1]) + (s3[2] + s3[3]));
                    rstd[m] = rsqrtf(st * (1.f / DM) + EPS); } }
            asm volatile("" ::: "memory");
#pragma unroll
            for (int m = 0; m < 4; ++m) {
                float* orow = out + (size_t)EPI_ROWS(ai, m) * DM + c0;
#pragma unroll
                for (int bj = 0; bj < 2; ++bj) {
                    const f32x4 a0 = acc[ai][bj][m][0], a1 = acc[ai][bj][m][1];
                    const u32x4 p = pw[m][bj], hh = hw[m][bj];
                    f32x4 y0, y1;
                    y0[0] = bf_lo(hh[0]) + sigmoidf_(rstd[m] * a0[0]) * bf_lo(p[0]); y0[1] = bf_hi(hh[0]) + sigmoidf_(rstd[m] * a0[1]) * bf_hi(p[0]);
                    y0[2] = bf_lo(hh[1]) + sigmoidf_(rstd[m] * a0[2]) * bf_lo(p[1]); y0[3] = bf_hi(hh[1]) + sigmoidf_(rstd[m] * a0[3]) * bf_hi(p[1]);
                    y1[0] = bf_lo(hh[2]) + sigmoidf_(rstd[m] * a1[0]) * bf_lo(p[2]); y1[1] = bf_hi(hh[2]) + sigmoidf_(rstd[m] * a1[1]) * bf_hi(p[2]);
                    y1[2] = bf_lo(hh[3]) + sigmoidf_(rstd[m] * a1[2]) * bf_lo(p[3]); y1[3] = bf_hi(hh[3]) + sigmoidf_(rstd[m] * a1[3]) * bf_hi(p[3]);
                    __builtin_nontemporal_store(y0, (f32x4*)(orow + 32 * bj)); __builtin_nontemporal_store(y1, (f32x4*)(orow + 32 * bj + 4));
                }
            }
            asm volatile("" ::: "memory");
        }
    }
};
#undef EPI_ROWS
}

constexpr int RING_BYTES = 131072;
constexpr int TBL_OFF = RING_BYTES + 512;
constexpr int LDS_BYTES = 147456;
constexpr int NWAVES = 8;

__device__ __forceinline__ int crow(int r, int hi) { return (r & 3) + 8 * (r >> 2) + 4 * hi; }
typedef short v4i16_t __attribute__((ext_vector_type(4)));
__device__ __forceinline__ s16x4 vtr(const LAS unsigned char* p) { return __builtin_bit_cast(s16x4, __builtin_amdgcn_ds_read_tr16_b64_v4i16((LAS v4i16_t*)p)); }

template <bool WIN>
__device__ __forceinline__ void attn_item(bf16_t* U, const float* sink, int ci, int h, LAS unsigned char* wl, const LAS float* tbl, int lane_in) {
    constexpr int NB = WIN ? 2 : 8, NS = 2 * (NB + 1);
    int lane = lane_in; asm volatile("" : "+v"(lane));
    const int r32 = lane & 31, hi = lane >> 5;
    const bool samp = ci >= 512; const int sb = ci - 512;
    int row0, tmin;
    if (!samp) { const int c = ci & 255; row0 = (ci >> 8) * 16384 + 64 * c; tmin = (NB - c) > 0 ? (NB - c) : 0; } else { row0 = MP + 64 * sb; tmin = 0; }
    const int qcol = WIN ? (C_QA + 64 * h) : (C_QB + 64 * h);
    const int kcol = WIN ? (C_KA + 64 * (h >> 2)) : (C_KB + 64 * h);
    const int vcol = WIN ? (C_VA + 64 * (h >> 2)) : (C_VB + 64 * h);
    const int zcol = WIN ? (C_ZA + 64 * h) : (C_ZB + 64 * h);
    unsigned koff[4], voff[4];
#pragma unroll
    for (int i = 0; i < 4; ++i) { const int key = 8 * i + (lane >> 3), ch = (lane & 7) ^ ((key >> 1) & 7); koff[i] = (unsigned)(key * LDU + kcol + ch * 8); }
#pragma unroll
    for (int i = 0; i < 4; ++i) { const int dh = i >> 1, kg = i & 1; voff[i] = (unsigned)((16 * kg + (lane >> 2)) * LDU + vcol + 32 * dh + 8 * (lane & 3)); }
#define ATT_KROW(s_) ((((samp) && ((s_) >> 1) < NB) ? (CACHE_ROW0 + 512 * sb + 512 - 64 * (NB - ((s_) >> 1))) : (row0 - 64 * (NB - ((s_) >> 1)))) + 32 * ((s_) & 1))
#define ATT_DMA(s_) do { const bf16_t* kb_ = U + (size_t)ATT_KROW(s_) * LDU; LAS unsigned char* wb_ = wl + ((s_) & 1) * 8192; \
        _Pragma("unroll") for (int i_ = 0; i_ < 4; ++i_) __builtin_amdgcn_global_load_lds((const unsigned*)(kb_ + koff[i_]), (LAS unsigned*)(wb_ + i_ * 1024), 16, 0, 0); \
        _Pragma("unroll") for (int i_ = 0; i_ < 4; ++i_) __builtin_amdgcn_global_load_lds((const unsigned*)(kb_ + voff[i_]), (LAS unsigned*)(wb_ + 4096 + i_ * 1024), 16, 0, 0); } while (0)
    const int smin = 2 * tmin;
    asm volatile("s_waitcnt lgkmcnt(0)" ::: "memory");
    ATT_DMA(smin); ATT_DMA(smin + 1);
    bf16x8 qr[2][4];
#pragma unroll
    for (int qh = 0; qh < 2; ++qh)
#pragma unroll
        for (int d0 = 0; d0 < 4; ++d0) qr[qh][d0] = *(const bf16x8*)(U + (size_t)(row0 + 32 * qh + r32) * LDU + qcol + 16 * d0 + 8 * hi);
    u32x2 zr[2][2][4];
#pragma unroll
    for (int qh = 0; qh < 2; ++qh)
#pragma unroll
        for (int dh = 0; dh < 2; ++dh)
#pragma unroll
            for (int g = 0; g < 4; ++g) zr[qh][dh][g] = *(const u32x2*)(U + (size_t)(row0 + 32 * qh + r32) * LDU + 4 * hi + zcol + 32 * dh + 8 * g);
    f32x16 o[2][2];
#pragma unroll
    for (int a = 0; a < 2; ++a)
#pragma unroll
        for (int b = 0; b < 2; ++b)
#pragma unroll
            for (int r = 0; r < 16; ++r) o[a][b][r] = 0.f;
    float lrun[2];
    const float slope2 = WIN ? (LOG2E * __builtin_amdgcn_exp2f(-(float)(h + 1))) : 0.f;
    if (WIN) { lrun[0] = hi == 0 ? fast_exp2(sink[h] * LOG2E) : 0.f; lrun[1] = lrun[0]; }
    else { lrun[0] = 0.f; lrun[1] = 0.f; }
    const LAS float* th = tbl + h * 257;
    int kfo[4];
#pragma unroll
    for (int d0 = 0; d0 < 4; ++d0) kfo[d0] = r32 * 128 + (((2 * d0 + hi) ^ ((r32 >> 1) & 7)) * 16);
    const int vfo = 4096 + ((lane >> 4) & 1) * 32 + (lane & 3) * 8 + (4 * hi + ((lane & 15) >> 2)) * 64;
#pragma unroll 1
    for (int s = smin; s < NS; ++s) {
        if (s + 1 < NS) asm volatile("s_waitcnt vmcnt(8)" ::: "memory"); else asm volatile("s_waitcnt vmcnt(0)" ::: "memory");
        const LAS unsigned char* wb = wl + (s & 1) * 8192;
        f32x16 Cq[2];
#pragma unroll
        for (int qh = 0; qh < 2; ++qh) {
            f32x16 C0;
            const int iq = 32 * qh + r32;
            const float nm = -slope2 * (float)(128 + iq);
            if (WIN) {
                if (s < 4) { const float b0 = slope2 * (float)(32 * s + 4 * hi) + nm;
#pragma unroll
                    for (int r = 0; r < 16; ++r) C0[r] = __builtin_fmaf(slope2, (float)((r & 3) + 8 * (r >> 2)), b0);
                } else { const int base = 128 + iq - 32 * s - 4 * hi; const float b1 = slope2 * (float)(128 + iq) + nm;
#pragma unroll
                    for (int r = 0; r < 16; ++r) { const int cr = (r & 3) + 8 * (r >> 2); C0[r] = __builtin_fmaf(-slope2, fabsf((float)(base - cr)), b1); } }
            } else {
                if (s < 12) {
#pragma unroll
                    for (int r = 0; r < 16; ++r) C0[r] = 0.f;
                } else {
                    const int base = 512 + iq - 32 * s - 4 * hi + 128;
#pragma unroll
                    for (int r = 0; r < 16; ++r) { const int cr = (r & 3) + 8 * (r >> 2); int i0 = base - cr; i0 = i0 > 256 ? 256 : i0; C0[r] = th[i0]; }
                }
            }
            Cq[qh] = C0;
        }
        {
            bf16x8 kf[4];
#pragma unroll
            for (int d0 = 0; d0 < 4; ++d0) kf[d0] = *(const LAS bf16x8*)(wb + kfo[d0]);
            asm volatile("s_waitcnt lgkmcnt(0)" ::: "memory");
            __builtin_amdgcn_sched_barrier(0);
            __builtin_amdgcn_s_setprio(1);
#pragma unroll
            for (int d0 = 0; d0 < 4; ++d0) {
                Cq[0] = __builtin_amdgcn_mfma_f32_32x32x16_bf16(kf[d0], qr[0][d0], Cq[0], 0, 0, 0);
                Cq[1] = __builtin_amdgcn_mfma_f32_32x32x16_bf16(kf[d0], qr[1][d0], Cq[1], 0, 0, 0);
            }
            __builtin_amdgcn_s_setprio(0);
        }
        __builtin_amdgcn_sched_barrier(0);
        bf16x8 vf[2][2];
        { s16x4 tl[4], tu[4];
            const unsigned va = (unsigned)(uintptr_t)(wb + vfo);
            asm volatile("ds_read_b64_tr_b16 %0, %8\n\tds_read_b64_tr_b16 %1, %8 offset:512\n\tds_read_b64_tr_b16 %2, %8 offset:1024\n\tds_read_b64_tr_b16 %3, %8 offset:1536\n\t"
                         "ds_read_b64_tr_b16 %4, %8 offset:2048\n\tds_read_b64_tr_b16 %5, %8 offset:2560\n\tds_read_b64_tr_b16 %6, %8 offset:3072\n\tds_read_b64_tr_b16 %7, %8 offset:3584\n\t"
                         "s_waitcnt lgkmcnt(0)"
                         : "=&v"(tl[0]), "=&v"(tu[0]), "=&v"(tl[1]), "=&v"(tu[1]), "=&v"(tl[2]), "=&v"(tu[2]), "=&v"(tl[3]), "=&v"(tu[3]) : "v"(va) : "memory");
#pragma unroll
            for (int i = 0; i < 4; ++i) vf[i >> 1][i & 1] = (bf16x8){tl[i][0], tl[i][1], tl[i][2], tl[i][3], tu[i][0], tu[i][1], tu[i][2], tu[i][3]}; }
        if (s + 2 < NS) ATT_DMA(s + 2);
#pragma unroll
        for (int qh = 0; qh < 2; ++qh) {
            f32x16 C0 = Cq[qh];
            typedef float f32x2v __attribute__((ext_vector_type(2)));
            f32x2v ps2 = (f32x2v){0.f, 0.f};
#pragma unroll
            for (int r = 0; r < 16; r += 2) { C0[r] = fast_exp2(C0[r]); C0[r + 1] = fast_exp2(C0[r + 1]); ps2 += (f32x2v){C0[r], C0[r + 1]}; }
            lrun[qh] += ps2.x + ps2.y;
            u32x4 w0, w1;
#pragma unroll
            for (int q = 0; q < 4; ++q) { w0[q] = cvt_pk_bf16(C0[2 * q], C0[2 * q + 1]); w1[q] = cvt_pk_bf16(C0[8 + 2 * q], C0[8 + 2 * q + 1]); }
            const bf16x8 pw0 = __builtin_bit_cast(bf16x8, w0), pw1 = __builtin_bit_cast(bf16x8, w1);
            __builtin_amdgcn_s_setprio(1);
#pragma unroll
            for (int dh = 0; dh < 2; ++dh) {
                o[qh][dh] = __builtin_amdgcn_mfma_f32_32x32x16_bf16(vf[dh][0], pw0, o[qh][dh], 0, 0, 0);
                o[qh][dh] = __builtin_amdgcn_mfma_f32_32x32x16_bf16(vf[dh][1], pw1, o[qh][dh], 0, 0, 0);
            }
            __builtin_amdgcn_s_setprio(0);
        }
    }
#undef ATT_DMA
#undef ATT_KROW
#pragma unroll
    for (int qh = 0; qh < 2; ++qh) {
        const float lt = lrun[qh] + __shfl_xor(lrun[qh], 32);
        const float inv = 1.f / lt;
        bf16_t* rowp = U + (size_t)(row0 + 32 * qh + r32) * LDU + 4 * hi;
#pragma unroll
        for (int dh = 0; dh < 2; ++dh)
#pragma unroll
            for (int g = 0; g < 4; ++g) {
                const int d = 32 * dh + 8 * g;
                const u32x2 z = zr[qh][dh][g];
                u32x2 w;
                w.x = cvt_pk_bf16(o[qh][dh][4 * g] * inv * bf_lo(z.x), o[qh][dh][4 * g + 1] * inv * bf_hi(z.x));
                w.y = cvt_pk_bf16(o[qh][dh][4 * g + 2] * inv * bf_lo(z.y), o[qh][dh][4 * g + 3] * inv * bf_hi(z.y));
                *(u32x2*)(rowp + qcol + d) = w;
            }
    }
}

__device__ __forceinline__ unsigned f2bf(float f) { unsigned u = __builtin_bit_cast(unsigned, f); return (u + 0x7fffu + ((u >> 16) & 1u)) >> 16; }
__device__ __forceinline__ unsigned pk2(float lo, float hi) { return f2bf(lo) | (f2bf(hi) << 16); }
__device__ __forceinline__ int permrow(int n) { return (n & ~255) | ((((n >> 5) & 1) * 128) + (((n >> 6) & 3) * 32) + (n & 31)); }
__device__ __forceinline__ void p0_transpose_item(const float* W, int N, bf16_t* WT, int ldt, int col_off, const float* kscale, LAS float* scr, int item, int lane, int nscale_from = -1) {
    const int nblk = N / 32, kb = item / nblk, nb = item % nblk, k0 = 64 * kb, n0 = 32 * nb;
#pragma unroll 16
    for (int i = 0; i < 32; ++i) { const int kk = 2 * i + (lane >> 5); const float s = (kscale ? kscale[k0 + kk] : 1.f) * ((nscale_from >= 0 && n0 >= nscale_from) ? -LOG2E : 1.f); scr[kk * 33 + (lane & 31)] = __builtin_nontemporal_load(W + (size_t)(k0 + kk) * N + n0 + (lane & 31)) * s; }
    asm volatile("s_waitcnt lgkmcnt(0)" ::: "memory");
    const int c = lane & 7;
#pragma unroll
    for (int j = 0; j < 4; ++j) { const int n = (lane >> 3) + 8 * j; const LAS float* s = scr + (8 * c) * 33 + n;
        u32x4 o; o.x = pk2(s[0 * 33], s[1 * 33]); o.y = pk2(s[2 * 33], s[3 * 33]); o.z = pk2(s[4 * 33], s[5 * 33]); o.w = pk2(s[6 * 33], s[7 * 33]);
        *(u32x4*)(WT + (size_t)permrow(n0 + n) * ldt + col_off + k0 + 8 * c) = o; }
    asm volatile("s_waitcnt lgkmcnt(0)" ::: "memory");
}


#define XB_TMO      128
#define XB_XCNT(j)  (256  + 64 * (j))
#define XB_XSUB(j)  (1280 + 64 * (j))
#define XB_XGEN(j)  (2304 + 64 * (j))
#define XB_TOP      3328
#define XB_TOPGEN   3392
#define XCD_BAR_WORDS 3456
#define XB_SPIN_CAP (1u << 18)
__device__ __forceinline__ unsigned xb_ld(unsigned* p)              { return __hip_atomic_load(p, __ATOMIC_RELAXED, __HIP_MEMORY_SCOPE_AGENT); }
__device__ __forceinline__ unsigned xb_add(unsigned* p, unsigned v) { return __hip_atomic_fetch_add(p, v, __ATOMIC_RELAXED, __HIP_MEMORY_SCOPE_AGENT); }
__device__ __forceinline__ unsigned xb_xcc_id() { return (unsigned)__builtin_amdgcn_s_getreg((3 << 11) | 20) & 0xFu; }
#define XB_SPIN(cond, bar) do { unsigned _sp = 0; while (cond) { __builtin_amdgcn_s_sleep(1); \
    if ((++_sp & 255u) == 0u) { if (xb_ld(&(bar)[XB_TMO])) break; if (_sp > XB_SPIN_CAP) { atomicAdd(&(bar)[XB_TMO], 1u); break; } } } } while (0)
struct XcdBarrier { unsigned* bar; unsigned x; volatile LAS unsigned* st; };
__device__ __forceinline__ XcdBarrier xcd_barrier_post(unsigned* bar, volatile LAS unsigned* st) {
    XcdBarrier b; b.bar = bar; b.x = xb_xcc_id(); b.st = st;
    if (threadIdx.x == 0) (void)xb_add(&bar[XB_XCNT(b.x)], 1u);
    return b;
}
__device__ __forceinline__ void xcd_barrier_complete(unsigned* bar, unsigned x, unsigned& nloc, unsigned& nx) {
    const unsigned G = gridDim.x * gridDim.y * gridDim.z;
    unsigned sum, cnt, mine, sp = 0u;
    for (;;) {
        sum = 0u; cnt = 0u; mine = 0u;
#pragma unroll
        for (unsigned j = 0; j < 16; ++j) { const unsigned c = xb_ld(&bar[XB_XCNT(j)]); sum += c; cnt += (c > 0u) ? 1u : 0u; mine = (j == x) ? c : mine; }
        if (sum == G) break;
        __builtin_amdgcn_s_sleep(1);
        if ((++sp & 255u) == 0u) { if (xb_ld(&bar[XB_TMO])) break; if (sp > XB_SPIN_CAP) { atomicAdd(&bar[XB_TMO], 1u); break; } }
    }
    nloc = mine > 0u ? mine : 1u; nx = cnt > 0u ? cnt : 1u;
}
__device__ __forceinline__ void xcd_barrier(const XcdBarrier& b) {
    asm volatile("s_waitcnt vmcnt(0)" ::: "memory");
    __syncthreads();
    if (threadIdx.x == 0) {
        unsigned* bar = b.bar;
        __builtin_amdgcn_s_waitcnt(0);
        unsigned nloc = b.st[0], nx = b.st[1];
        if (nloc == 0u) { xcd_barrier_complete(bar, b.x, nloc, nx); b.st[0] = nloc; b.st[1] = nx; }
        const unsigned old = xb_add(&bar[XB_XSUB(b.x)], 1u);
        const unsigned gen = old / nloc;
        if (old + 1u == (gen + 1u) * nloc) {
            __builtin_amdgcn_fence(__ATOMIC_RELEASE, "agent");
            asm volatile("s_waitcnt vmcnt(0)" ::: "memory");
            const unsigned og = xb_add(&bar[XB_TOP], 1u);
            const unsigned tg = og / nx;
            if (og + 1u == (tg + 1u) * nx) xb_add(&bar[XB_TOPGEN], 1u);
            else XB_SPIN(xb_ld(&bar[XB_TOPGEN]) == tg, bar);
            __builtin_amdgcn_fence(__ATOMIC_ACQUIRE, "agent");
            xb_add(&bar[XB_XGEN(b.x)], 1u);
            asm volatile("s_waitcnt vmcnt(0)" ::: "memory");
        } else {
            XB_SPIN(xb_ld(&bar[XB_XGEN(b.x)]) == gen, bar);
            __builtin_amdgcn_fence(__ATOMIC_ACQUIRE, "agent");
            asm volatile("s_waitcnt vmcnt(0)" ::: "memory");
        }
    }
    __syncthreads();
}

template <int KSTEPS>
__device__ __forceinline__ void tail_partial(const bf16_t* A, int lda, const bf16_t* Bt, int ldb, int col0, LAS float* part, int lane) {
    const int fr = lane & 15, fq = lane >> 4;
    f32x4 acc[2][4];
#pragma unroll
    for (int m = 0; m < 2; ++m)
#pragma unroll
        for (int n = 0; n < 4; ++n) acc[m][n] = (f32x4){0.f, 0.f, 0.f, 0.f};
    const bf16_t* ap = A + (size_t)fr * lda + 8 * fq;
    const bf16_t* bp[4];
#pragma unroll
    for (int n = 0; n < 4; ++n) bp[n] = Bt + (size_t)permrow(col0 + 16 * n + fr) * ldb + 8 * fq;
#pragma unroll
    for (int ks = 0; ks < KSTEPS; ++ks) {
        bf16x8 a[2], b[4];
#pragma unroll
        for (int m = 0; m < 2; ++m) a[m] = *(const bf16x8*)(ap + (size_t)(16 * m) * lda + 32 * ks);
#pragma unroll
        for (int n = 0; n < 4; ++n) b[n] = *(const bf16x8*)(bp[n] + 32 * ks);
#pragma unroll
        for (int m = 0; m < 2; ++m)
#pragma unroll
            for (int n = 0; n < 4; ++n) acc[m][n] = __builtin_amdgcn_mfma_f32_16x16x32_bf16(b[n], a[m], acc[m][n], 0, 0, 0);
    }
#pragma unroll
    for (int m = 0; m < 2; ++m)
#pragma unroll
        for (int n = 0; n < 4; ++n) *(LAS f32x4*)(part + (16 * m + fr) * 64 + 16 * n + 4 * fq) = acc[m][n];
}
__device__ __forceinline__ f32x4 tail_sum(const LAS float* parts, int w0, int w1, int tid) {
    f32x4 s = (f32x4){0.f, 0.f, 0.f, 0.f};
    for (int w = w0; w < w1; ++w) s += *(const LAS f32x4*)(parts + w * 2048 + tid * 4);
    return s;
}

__device__ __forceinline__ int fresh_tid() { int t = threadIdx.x; asm volatile("" : "+v"(t)); return t; }

struct Args {
    const float* in[22]; float* out; unsigned char* ws;
};

__global__ void __launch_bounds__(NWAVES * 64, 2) fwd_megakernel(Args args) {
    extern __shared__ __attribute__((aligned(16))) unsigned char lds_raw[];
    LAS unsigned char* lds = (LAS unsigned char*)lds_raw;
    const int G = gridDim.x, bx = blockIdx.x;
    const int NGW = G * NWAVES;
#define PHASE_IDS() const int tid = fresh_tid(), lane = tid & 63, wave = __builtin_amdgcn_readfirstlane(tid >> 6), gw = bx * NWAVES + wave; (void)lane; (void)gw
    unsigned char* ws = args.ws;
    volatile LAS unsigned* bar_st = (volatile LAS unsigned*)(lds + RING_BYTES + 32);
    unsigned* bar_words = (unsigned*)ws;
    if (threadIdx.x < 2) bar_st[threadIdx.x] = 0u;
    __syncthreads();
    const XcdBarrier xbar = xcd_barrier_post(bar_words, bar_st);
    const float* x_prompt = args.in[0]; const float* x_sample = args.in[1];
    const float* ck_win = args.in[2]; const float* cv_win = args.in[3]; const float* ck_band = args.in[4]; const float* cv_band = args.in[5];
    const float* p_prompt = args.in[6]; const float* p_sample = args.in[7];
    const float* g_in = args.in[8]; const float* w_in = args.in[9]; const float* g_q_win = args.in[10]; const float* g_k_win = args.in[11];
    const float* sink_win = args.in[12]; const float* g_q_band = args.in[13]; const float* g_k_band = args.in[14]; const float* rel_bias = args.in[15];
    const float* w_o_win = args.in[16]; const float* w_o_band = args.in[17]; const float* w_out = args.in[18]; const float* g_ple = args.in[19];
    const float* w_ple_gate = args.in[20]; const float* w_ple = args.in[21];
    float* out = args.out;
    bf16_t* Win_t = (bf16_t*)(ws + WS_WIN); bf16_t* WO_t = (bf16_t*)(ws + WS_WO); bf16_t* Wout_t = (bf16_t*)(ws + WS_WOUT); bf16_t* WGP_t = (bf16_t*)(ws + WS_WGP);
    float* SS = (float*)(ws + WS_SS); bf16_t* R1 = (bf16_t*)(ws + WS_R1); bf16_t* U = (bf16_t*)(ws + WS_U); bf16_t* HP = (bf16_t*)(ws + WS_U);

    {
        PHASE_IDS();
        LAS float* scr = (LAS float*)(lds + wave * 16384);
        constexpr int I_IN = 16 * (NIN / 32);
        for (int it = gw; it < I_IN; it += NGW) p0_transpose_item(w_in, NIN, Win_t, 1024, 0, g_in, scr, it, lane, C_GA);
        if (gw == 0) { float* GT = (float*)(ws + WS_GT); GT[lane] = g_q_win[lane]; GT[64 + lane] = g_k_win[lane]; GT[128 + lane] = g_q_band[lane]; GT[192 + lane] = g_k_band[lane]; }
        for (int m0 = gw * 4; m0 < MP; m0 += NGW * 4) {
            f32x4 v[4][4]; float s2[4];
#pragma unroll
            for (int q = 0; q < 4; ++q) {
                const int m = m0 + q;
                const float* xrow = (m < MP) ? (x_prompt + (size_t)m * DM) : (x_sample + (size_t)(m - MP) * DM);
                const f32x4* xr = (const f32x4*)xrow + lane;
#pragma unroll
                for (int j = 0; j < 4; ++j) v[q][j] = __builtin_nontemporal_load(xr + 64 * j);
            }
#pragma unroll
            for (int q = 0; q < 4; ++q) { s2[q] = 0.f;
#pragma unroll
                for (int j = 0; j < 4; ++j) s2[q] += (v[q][j][0] * v[q][j][0] + v[q][j][1] * v[q][j][1]) + (v[q][j][2] * v[q][j][2] + v[q][j][3] * v[q][j][3]); }
#pragma unroll
            for (int q = 0; q < 4; ++q) {
                const float rstd = rsqrtf(wave_sum(s2[q]) * (1.f / DM) + EPS);
                u32x2* o8 = (u32x2*)(R1 + (size_t)(m0 + q) * DM) + lane;
#pragma unroll
                for (int j = 0; j < 4; ++j) { u32x2 w; w.x = pk2(v[q][j][0] * rstd, v[q][j][1] * rstd); w.y = pk2(v[q][j][2] * rstd, v[q][j][3] * rstd); o8[64 * j] = w; }
            }
        }
        for (int m = MP + gw; m < M; m += NGW) {
            const f32x4* xr = (const f32x4*)(x_sample + (size_t)(m - MP) * DM) + lane;
            f32x4 v[4]; float s2 = 0.f;
#pragma unroll
            for (int j = 0; j < 4; ++j) { v[j] = __builtin_nontemporal_load(xr + 64 * j); s2 += (v[j][0] * v[j][0] + v[j][1] * v[j][1]) + (v[j][2] * v[j][2] + v[j][3] * v[j][3]); }
            const float rstd = rsqrtf(wave_sum(s2) * (1.f / DM) + EPS);
            u32x2* o8 = (u32x2*)(R1 + (size_t)m * DM) + lane;
#pragma unroll
            for (int j = 0; j < 4; ++j) { u32x2 w; w.x = pk2(v[j][0] * rstd, v[j][1] * rstd); w.y = pk2(v[j][2] * rstd, v[j][3] * rstd); o8[64 * j] = w; }
        }
    }
    xcd_barrier(xbar);

    for (int rep = 0; rep < (PROBE_MODE == 1 ? 2 : 1); ++rep) {
    {
        pg8::Gemm g{R1, Win_t, DM, DM};
        pg8::StaticOrder S; S.init(M, NIN, G, bx, 1);
        pg8::EpiIn E{U, out, (const float*)(ws + WS_GT)};
        pg8::gemm_phase<pg8::EpiIn, 0, 0, 16, 0, 0, 16>(lds, g, S, E, fresh_tid());
        {
            PHASE_IDS();
            const int nwg_ = (M / 256) * (NIN / 256), idle0 = nwg_ % G;
            const bool use_idle = (idle0 != 0) && (G - idle0 >= 32);
            const int dw0 = use_idle ? idle0 : 0, dnw = use_idle ? (G - idle0) : G, dwb = bx - dw0;
            if (bx >= dw0) {
                LAS float* scr = (LAS float*)(lds + wave * 16384);
                constexpr int I_OW = 8 * 32, I_OUT = 16 * 32, I_G = 16 * 32, I_P = 4 * 32, NDEF = 2 * I_OW + I_OUT + I_G + I_P;
                for (int it = dwb * NWAVES + wave; it < NDEF; it += dnw * NWAVES) {
                    int r = it;
                    if (r < I_OW) { p0_transpose_item(w_o_win, DM, WO_t, 1024, 0, nullptr, scr, r, lane); continue; } r -= I_OW;
                    if (r < I_OW) { p0_transpose_item(w_o_band, DM, WO_t, 1024, 512, nullptr, scr, r, lane); continue; } r -= I_OW;
                    if (r < I_OUT) { p0_transpose_item(w_out, DM, Wout_t, 1024, 0, nullptr, scr, r, lane); continue; } r -= I_OUT;
                    if (r < I_G) { p0_transpose_item(w_ple_gate, DM, WGP_t, LDHP, 0, g_ple, scr, r, lane); continue; } r -= I_G;
                    p0_transpose_item(w_ple, DM, WGP_t, LDHP, 1024, nullptr, scr, r, lane);
                }
                const int gt = dwb * (NWAVES * 64) + tid, NGT = dnw * NWAVES * 64;
                for (int e = gt; e < 8 * 128 * 128 / 4; e += NGT) {
                    const int b = e / (128 * 32), rem = e % (128 * 32), j = rem / 32, c4 = (rem % 32) * 4;
                    const f32x4 k = __builtin_nontemporal_load((const f32x4*)(ck_win + (size_t)e * 4)), v = __builtin_nontemporal_load((const f32x4*)(cv_win + (size_t)e * 4));
                    bf16_t* urow = U + (size_t)(CACHE_ROW0 + 512 * b + 384 + j) * LDU;
                    u32x2 wk; wk.x = pk2(k[0], k[1]); wk.y = pk2(k[2], k[3]); u32x2 wv; wv.x = pk2(v[0], v[1]); wv.y = pk2(v[2], v[3]);
                    *(u32x2*)(urow + C_KA + c4) = wk; *(u32x2*)(urow + C_VA + c4) = wv;
                    if (j >= 64) { __builtin_nontemporal_store(k, (f32x4*)(out + O_KWS + ((size_t)(b * 128 + j - 64) * 128 + c4))); __builtin_nontemporal_store(v, (f32x4*)(out + O_VWS + ((size_t)(b * 128 + j - 64) * 128 + c4))); }
                }
                for (int e0 = gt; e0 < 8 * 512 * 512 / 4; e0 += 4 * NGT) {
                    f32x4 kk[4], vv[4];
#pragma unroll
                    for (int q = 0; q < 4; ++q) { const int e = e0 + q * NGT; if (e < 8 * 512 * 512 / 4) { kk[q] = __builtin_nontemporal_load((const f32x4*)(ck_band + (size_t)e * 4)); vv[q] = __builtin_nontemporal_load((const f32x4*)(cv_band + (size_t)e * 4)); } }
#pragma unroll
                    for (int q = 0; q < 4; ++q) { const int e = e0 + q * NGT; if (e < 8 * 512 * 512 / 4) {
                        const int b = e / (512 * 128), rem = e % (512 * 128), j = rem / 128, c4 = (rem % 128) * 4;
                        const f32x4 k = kk[q], v = vv[q];
                        bf16_t* urow = U + (size_t)(CACHE_ROW0 + 512 * b + j) * LDU;
                        u32x2 wk; wk.x = pk2(k[0], k[1]); wk.y = pk2(k[2], k[3]); u32x2 wv; wv.x = pk2(v[0], v[1]); wv.y = pk2(v[2], v[3]);
                        *(u32x2*)(urow + C_KB + c4) = wk; *(u32x2*)(urow + C_VB + c4) = wv;
                        if (j >= 64) { __builtin_nontemporal_store(k, (f32x4*)(out + O_KBS + ((size_t)(b * 512 + j - 64) * 512 + c4))); __builtin_nontemporal_store(v, (f32x4*)(out + O_VBS + ((size_t)(b * 512 + j - 64) * 512 + c4))); } } }
                }
            }
        }
    }
    xcd_barrier(xbar);
    }

    {
        PHASE_IDS();
        LAS float* tbl = (LAS float*)(lds + TBL_OFF);
        for (int i = tid; i < 8 * 257; i += NWAVES * 64) tbl[i] = (rel_bias[i] - rel_bias[(i / 257) * 257 + 256]) * LOG2E;
        __syncthreads();
        LAS unsigned char* wl = lds + wave * 16384;
        if (NGW == 2048) {
            const int c0 = 65 * (bx & 7), wx = (bx >> 3) * NWAVES + wave;
#pragma unroll 1
            for (int k = 0; k < 3; ++k) { const int j = wx + 256 * k; if (j < 520) attn_item<false>(U, sink_win, c0 + (j >> 3), j & 7, wl, tbl, lane); }
            if (wx >= 8) { const int w2 = wx - 8;
#pragma unroll 1
                for (int k = 0; k < 3; ++k) { const int j = w2 + 248 * k; if (k < 2 || w2 < 24) attn_item<true>(U, sink_win, c0 + (j >> 3), j & 7, wl, tbl, lane); } }
        } else {
            for (int it = gw; it < 2 * 4160; it += NGW) {
                if (it < 4160) attn_item<false>(U, sink_win, it >> 3, it & 7, wl, tbl, lane);
                else { const int j = it - 4160; attn_item<true>(U, sink_win, j >> 3, j & 7, wl, tbl, lane); }
            }
        }
        __syncthreads();
    }
    xcd_barrier(xbar);

    for (int rep = 0; rep < (PROBE_MODE == 3 ? 2 : 1); ++rep) {
    {
        if (G == 256) {
            PHASE_IDS();
            const int tm = bx >> 4, tn = bx & 15, row0 = MP + 32 * tm, col0 = 64 * tn, br = wave >> 2, kw = (wave & 3) * 128;
            LAS float* parts = (LAS float*)lds;
            tail_partial<4>(U + (size_t)row0 * LDU + (br ? C_QB : C_QA) + kw, LDU, WO_t + br * 512 + kw, DM, col0, parts + wave * 2048, lane);
            __syncthreads();
            const f32x4 ca = tail_sum(parts, 0, 4, tid), cb = tail_sum(parts, 4, 8, tid);
            const int r = row0 + (tid >> 4), c = col0 + (tid & 15) * 4;
            const u32x2 ga = *(const u32x2*)(U + (size_t)r * LDU + C_GA + c), gb = *(const u32x2*)(U + (size_t)r * LDU + C_GB + c);
            u32x2 w;
            w.x = cvt_pk_bf16(bf_lo(ga.x) * ca[0] + bf_lo(gb.x) * cb[0], bf_hi(ga.x) * ca[1] + bf_hi(gb.x) * cb[1]);
            w.y = cvt_pk_bf16(bf_lo(ga.y) * ca[2] + bf_lo(gb.y) * cb[2], bf_hi(ga.y) * ca[3] + bf_hi(gb.y) * cb[3]);
            *(u32x2*)(R1 + (size_t)r * DM + c) = w;
            __syncthreads();
        }
        pg8::Gemm g{U, WO_t, LDU, DM};
        pg8::StaticOrder S; S.init(G == 256 ? MP : M, DM, G, bx, 2);
        pg8::EpiBranch E{U, R1};
        pg8::gemm_phase<pg8::EpiBranch, C_QA, 0, 8, C_QB, 512, 8>(lds, g, S, E, fresh_tid());
    }
    xcd_barrier(xbar);
    }

    for (int rep = 0; rep < (PROBE_MODE == 3 ? 2 : 1); ++rep) {
    {
        PHASE_IDS();
        for (int m0 = gw * 4; m0 < MP; m0 += NGW * 4) {
            f32x4 v[4];
#pragma unroll
            for (int q = 0; q < 4; ++q) v[q] = __builtin_nontemporal_load((const f32x4*)(p_prompt + (size_t)(m0 + q) * 256) + lane);
#pragma unroll
            for (int q = 0; q < 4; ++q) { u32x2 w; w.x = pk2(v[q][0], v[q][1]); w.y = pk2(v[q][2], v[q][3]); *((u32x2*)(HP + (size_t)(m0 + q) * LDHP + 1024) + lane) = w; }
        }
        for (int m = MP + gw; m < M; m += NGW) {
            const f32x4 v = *((const f32x4*)(p_sample + (size_t)(m - MP) * 256) + lane);
            u32x2 w; w.x = pk2(v[0], v[1]); w.y = pk2(v[2], v[3]);
            *((u32x2*)(HP + (size_t)m * LDHP + 1024) + lane) = w;
        }
        if (G == 256) {
            const int tm = bx >> 4, tn = bx & 15, row0 = MP + 32 * tm, col0 = 64 * tn, kw = wave * 128;
            LAS float* parts = (LAS float*)lds;
            tail_partial<4>(R1 + (size_t)row0 * DM + kw, DM, Wout_t + kw, DM, col0, parts + wave * 2048, lane);
            __syncthreads();
            const f32x4 cc = tail_sum(parts, 0, 8, tid);
            const int r = row0 + (tid >> 4), c = col0 + (tid & 15) * 4;
            const f32x4 h = cc + *(const f32x4*)(x_sample + (size_t)(r - MP) * DM + c);
            u32x2 w; w.x = cvt_pk_bf16(h[0], h[1]); w.y = cvt_pk_bf16(h[2], h[3]);
            *(u32x2*)(HP + (size_t)r * LDHP + c) = w;
            float ss = (h[0] * h[0] + h[1] * h[1]) + (h[2] * h[2] + h[3] * h[3]);
            ss += __shfl_xor(ss, 1); ss += __shfl_xor(ss, 2); ss += __shfl_xor(ss, 4); ss += __shfl_xor(ss, 8);
            if ((tid & 15) == 0) SS[(size_t)r * 16 + tn] = ss;
            __syncthreads();
        }
        pg8::Gemm g{R1, Wout_t, DM, DM};
        pg8::StaticOrder S; S.init(G == 256 ? MP : M, DM, G, bx, 1);
        pg8::EpiOut E{x_prompt, x_sample, HP, SS};
        pg8::gemm_phase<pg8::EpiOut, 0, 0, 16, 0, 0, 16>(lds, g, S, E, fresh_tid());
    }
    xcd_barrier(xbar);
    }

    {
        if (G == 256) {
            PHASE_IDS();
            const int tm = bx >> 4, tn = bx & 15, row0 = MP + 32 * tm, col0 = 64 * tn;
            LAS float* parts = (LAS float*)lds;
            tail_partial<1>(HP + (size_t)row0 * LDHP + 1024 + wave * 32, LDHP, WGP_t + 1024 + wave * 32, LDHP, col0, parts + wave * 2048, lane);
            __syncthreads();
            const f32x4 ple = tail_sum(parts, 0, 8, tid);
            __syncthreads();
            tail_partial<4>(HP + (size_t)row0 * LDHP + wave * 128, LDHP, WGP_t + wave * 128, LDHP, col0, parts + wave * 2048, lane);
            __syncthreads();
            const f32x4 cc = tail_sum(parts, 0, 8, tid);
            const int r = row0 + (tid >> 4), c = col0 + (tid & 15) * 4;
            const f32x4* sp = (const f32x4*)(SS + (size_t)r * 16);
            const f32x4 s0 = sp[0], s1 = sp[1], s2 = sp[2], s3 = sp[3];
            const float st = ((s0[0] + s0[1]) + (s0[2] + s0[3])) + ((s1[0] + s1[1]) + (s1[2] + s1[3])) + ((s2[0] + s2[1]) + (s2[2] + s2[3])) + ((s3[0] + s3[1]) + (s3[2] + s3[3]));
            const float rstd = rsqrtf(st * (1.f / DM) + EPS);
            const u32x2 hw = *(const u32x2*)(HP + (size_t)r * LDHP + c);
            f32x4 y;
            y[0] = bf_lo(hw.x) + sigmoidf_(rstd * cc[0]) * ple[0]; y[1] = bf_hi(hw.x) + sigmoidf_(rstd * cc[1]) * ple[1];
            y[2] = bf_lo(hw.y) + sigmoidf_(rstd * cc[2]) * ple[2]; y[3] = bf_hi(hw.y) + sigmoidf_(rstd * cc[3]) * ple[3];
            *(f32x4*)(out + (size_t)r * DM + c) = y;
            __syncthreads();
        }
        pg8::Gemm g{HP, WGP_t, LDHP, LDHP};
        pg8::StaticOrder S; S.init(G == 256 ? MP : M, DM, G, bx, 2);
        LAS float* rs = nullptr;
        if (G == 256) {
            const int t2 = fresh_tid();
            rs = (LAS float*)(lds + TBL_OFF);
            pg8::Unit uu; if (S.next(2 * (t2 >> 8), uu)) {
                const int r = uu.pm * 256 + (t2 & 255);
                const f32x4* sp = (const f32x4*)(SS + (size_t)r * 16); const f32x4 s0 = sp[0], s1 = sp[1], s2 = sp[2], s3 = sp[3];
                const float st = ((s0[0] + s0[1]) + (s0[2] + s0[3])) + ((s1[0] + s1[1]) + (s1[2] + s1[3])) + ((s2[0] + s2[1]) + (s2[2] + s2[3])) + ((s3[0] + s3[1]) + (s3[2] + s3[3]));
                rs[t2] = rsqrtf(st * (1.f / DM) + EPS); }
            __syncthreads();
        }
        pg8::EpiFinal E{out, R1, SS, HP, rs};
        pg8::gemm_phase<pg8::EpiFinal, 1024, 1024, 4, 0, 0, 16>(lds, g, S, E, fresh_tid());
    }
}

extern "C" void kernel_launch(void* const* d_in, const int* in_sizes, int n_in, void* d_out, int out_size, void* d_ws, size_t ws_size, hipStream_t stream) {
    static int grid = 0;
    if (grid == 0) {
        if (n_in != 22 || out_size != (int)O_END || ws_size < WS_END) { fprintf(stderr, "kernel_launch: unexpected sizes n_in %d out %d ws %zu (need %zu)\n", n_in, out_size, ws_size, (size_t)WS_END); grid = -1; return; }
        int dev = 0, cus = 0, per_cu = 0;
        hipGetDevice(&dev);
        hipDeviceGetAttribute(&cus, hipDeviceAttributeMultiprocessorCount, dev);
        hipFuncSetAttribute((const void*)fwd_megakernel, hipFuncAttributeMaxDynamicSharedMemorySize, LDS_BYTES);
        hipOccupancyMaxActiveBlocksPerMultiprocessor(&per_cu, (const void*)fwd_megakernel, NWAVES * 64, LDS_BYTES);
        if (per_cu < 1) { fprintf(stderr, "kernel_launch: occupancy query says %d blocks per CU\n", per_cu); per_cu = 1; }
        grid = cus;
    }
    if (grid < 0) return;
    Args a{};
    for (int i = 0; i < 22; ++i) a.in[i] = (const float*)d_in[i];
    a.out = (float*)d_out; a.ws = (unsigned char*)d_ws;
    if (hipMemsetAsync(d_ws, 0, XCD_BAR_WORDS * sizeof(unsigned), stream) != hipSuccess) { fprintf(stderr, "kernel_launch: memset of the barrier words failed\n"); return; }
    void* kargs[] = {&a};
    hipError_t e = hipLaunchCooperativeKernel((const void*)fwd_megakernel, dim3(grid), dim3(NWAVES * 64), kargs, LDS_BYTES, stream);
    if (e != hipSuccess) fprintf(stderr, "cooperative launch failed: %s (grid %d)\n", hipGetErrorString(e), grid);
}
```

```cpp
#include <hip/hip_runtime.h>
#include <hip/hip_cooperative_groups.h>
#include <cstdio>
#include <cstdint>
namespace cg = cooperative_groups;
#ifndef PROBE_MODE
#define PROBE_MODE 0
#endif

#define LAS __attribute__((address_space(3)))
#define GAS __attribute__((address_space(1)))
typedef unsigned short bf16_t;
typedef short bf16x8 __attribute__((ext_vector_type(8)));
typedef short s16x4 __attribute__((ext_vector_type(4)));
typedef float f32x4 __attribute__((ext_vector_type(4)));
typedef float f32x16 __attribute__((ext_vector_type(16)));
typedef unsigned u32x4 __attribute__((ext_vector_type(4)));
typedef unsigned u32x2 __attribute__((ext_vector_type(2)));

constexpr int MP = 32768, MS = 512, M = MP + MS;
constexpr int DM = 1024, NIN = 5376, LDU = NIN;
constexpr int CACHE_ROW0 = M;
constexpr int UROWS = M + 8 * 512;
constexpr int LDHP = 1280;
constexpr float EPS = 1e-6f;
constexpr float LOG2E = 1.4426950408889634f;
constexpr float ATT_THR = 8.f;
constexpr float C2 = 0.125f * LOG2E;
constexpr size_t O_Y = 0, O_KWP = 34078720, O_VWP = 34111488, O_KBP = 34144256, O_VBP = 34668544,
                 O_KWS = 35192832, O_VWS = 35323904, O_KBS = 35454976, O_VBS = 37552128, O_END = 39649280;
constexpr int C_QA = 0, C_KA = 512, C_VA = 640, C_ZA = 768, C_QB = 1280, C_KB = 1792, C_VB = 2304, C_ZB = 2816, C_GA = 3328, C_GB = 4352;

constexpr size_t MiB = 1u << 20;
constexpr size_t WS_GT = 1 * MiB;
constexpr size_t WS_WIN = 2 * MiB;
constexpr size_t WS_WO = 13 * MiB;
constexpr size_t WS_WOUT = 15 * MiB;
constexpr size_t WS_WGP = 17 * MiB;
constexpr size_t WS_SS = 20 * MiB;
constexpr size_t WS_R1 = 24 * MiB;
constexpr size_t WS_U = 90 * MiB;
constexpr size_t WS_END = WS_U + (size_t)UROWS * LDU * 2;
static_assert(WS_END <= 512 * MiB, "d_ws map");

typedef float f32x2_t __attribute__((ext_vector_type(2))); typedef __bf16 bf16x2_t __attribute__((ext_vector_type(2)));
__device__ __forceinline__ unsigned cvt_pk_bf16(float lo, float hi) { const f32x2_t v = {lo, hi}; const bf16x2_t b = __builtin_convertvector(v, bf16x2_t); return __builtin_bit_cast(unsigned, b); }
__device__ __forceinline__ float bf_lo(unsigned w) { return __uint_as_float(w << 16); }
__device__ __forceinline__ float bf_hi(unsigned w) { return __uint_as_float(w & 0xffff0000u); }
__device__ __forceinline__ float fast_exp2(float x) { return __builtin_amdgcn_exp2f(x); }
__device__ __forceinline__ float fast_rcp(float x) { return __builtin_amdgcn_rcpf(x); }
__device__ __forceinline__ float sigmoidf_(float x) { return fast_rcp(1.f + fast_exp2(-LOG2E * x)); }
__device__ __forceinline__ float wave_sum(float v) {
#pragma unroll
    for (int o = 1; o < 64; o <<= 1) v += __shfl_xor(v, o);
    return v;
}

namespace pg8 {
constexpr int BM = 256, BK = 64, HALF = 128, HTB = HALF * BK * 2, STAGE_BYTES = 8 * HTB, NXCD = 8, WGM = 8;
__host__ __device__ __forceinline__ int lds_byte(int r, int c) { const int st = (r >> 4) * 2 + (c >> 5), rr = r & 15, cc = c & 31, ob = rr * 64 + cc * 2; return st * 1024 + (ob ^ (((ob >> 9) & 1) << 5)); }
__host__ __device__ __forceinline__ void stage_rc(int b, int& R, int& C) { const int st = b / 1024, sb = b % 1024, swz = sb ^ (((sb >> 9) & 1) << 5); R = (st >> 1) * 16 + swz / 64; C = (st & 1) * 32 + (swz % 64) / 2; }
__host__ __device__ __forceinline__ int perm32(int rho) { const int n = rho >> 4, i = rho & 15; return 8 * (i >> 2) + 4 * n + (i & 3); }

struct Unit { int pm, pn, seg, ti; };
struct Gemm { const bf16_t* A; const bf16_t* Bt; int lda, ldb; };

struct StaticOrder {
    int nM, nN, nwg, G, c, nseg;
    __device__ void init(int M_, int N_, int G_, int c_, int nseg_) { nM = M_ / BM; nN = N_ / BM; nwg = nM * nN; G = G_; c = c_; nseg = nseg_; }
    __device__ bool next(int i, Unit& u) const {
        const int it = (nseg == 2) ? (i >> 1) : i;
        const long L = (long)it * G + c; if (L >= nwg) return false;
        int wgid = (int)L; { const int q = nwg / NXCD, r = nwg % NXCD, xcd = wgid % NXCD, off = wgid / NXCD; wgid = (xcd < r ? xcd * (q + 1) : r * (q + 1) + (xcd - r) * q) + off; }
        const int nig = WGM * nN, gid = wgid / nig, fm = gid * WGM, gsz = (nM - fm) < WGM ? (nM - fm) : WGM;
        u.pm = fm + ((wgid % nig) % gsz); u.pn = (wgid % nig) / gsz; u.seg = (nseg == 2) ? (i & 1) : 0; u.ti = it; return true;
    }
};

template <class Epi, int AC0, int BC0, int NT0, int AC1, int BC1, int NT1>
__device__ __forceinline__ void gemm_phase(LAS unsigned char* lds, const Gemm g, const StaticOrder& S, const Epi& E, int tid) {
    const int wid = __builtin_amdgcn_readfirstlane(tid >> 6), lane = tid & 63, wr = wid >> 2, wc = wid & 3, fr = lane & 15, fq = lane >> 4;
    unsigned voffA[2], voffB[2];
#pragma unroll
    for (int i = 0; i < 2; ++i) { int R, C; stage_rc(tid * 16 + i * 8192, R, C); const int Rb = (R & ~31) + perm32(R & 31);
        voffA[i] = (unsigned)(R * g.lda + C) * 2u; voffB[i] = (unsigned)(Rb * g.ldb + C) * 2u; }
    const size_t kstep = (size_t)(BK * 2);
    const size_t hstepA = (size_t)HALF * g.lda * 2, hstepB = (size_t)HALF * g.ldb * 2;
    const unsigned ldsw = (unsigned)wid * 1024u;
    const int aoff = lds_byte(wr * 64 + fr, fq * 8), boff = lds_byte(wc * 32 + fr, fq * 8);
#define PG8_SA(b, h) (((b) * 2 + (h)) * HTB)
#define PG8_SB(b, h) ((4 + (b) * 2 + (h)) * HTB)
#define PG8_STAGE(bufoff, gbase, voff) do { _Pragma("unroll") for (int _i = 0; _i < 2; ++_i) \
        __builtin_amdgcn_global_load_lds((const unsigned*)((const char*)(gbase) + (voff)[_i]), (LAS unsigned*)(lds + (bufoff) + ldsw + _i * 8192), 16, 0, 0); } while (0)
#define PG8_LDA(dst, b, h) do { _Pragma("unroll") for (int m = 0; m < 4; ++m) _Pragma("unroll") for (int k = 0; k < 2; ++k) dst[m][k] = *(const LAS bf16x8*)(lds + PG8_SA(b, h) + aoff + m * 2048 + k * 1024); } while (0)
#define PG8_LDB(dst, b, h) do { _Pragma("unroll") for (int n = 0; n < 2; ++n) _Pragma("unroll") for (int k = 0; k < 2; ++k) dst[n][k] = *(const LAS bf16x8*)(lds + PG8_SB(b, h) + boff + n * 2048 + k * 1024); } while (0)
#define PG8_MMA(ai, bj, At, Bt) do { __builtin_amdgcn_s_setprio(1); _Pragma("unroll") for (int m = 0; m < 4; ++m) _Pragma("unroll") for (int n = 0; n < 2; ++n) _Pragma("unroll") for (int k = 0; k < 2; ++k) \
        acc[ai][bj][m][n] = __builtin_amdgcn_mfma_f32_16x16x32_bf16(Bt[n][k], At[m][k], acc[ai][bj][m][n], 0, 0, 0); __builtin_amdgcn_s_setprio(0); } while (0)
#define PG8_WAIT_V(n) asm volatile("s_waitcnt vmcnt(" #n ")" ::: "memory")
#define PG8_WAIT_L(n) asm volatile("s_waitcnt lgkmcnt(" #n ")" ::: "memory")
#define PG8_BAR __builtin_amdgcn_s_barrier()
#define PG8_SCHED __builtin_amdgcn_sched_barrier(0)
#define PG8_APTR(u) ((const char*)g.A + ((size_t)(u).pm * 2 * hstepA + (size_t)(AC0 + (u).seg * (AC1 - AC0)) * 2))
#define PG8_BPTR(u) ((const char*)g.Bt + ((size_t)(u).pn * 2 * hstepB + (size_t)(BC0 + (u).seg * (BC1 - BC0)) * 2))
    Unit cur, nxt; int ui = 0;
    if (!S.next(0, cur)) return;
    f32x4 acc[2][2][4][2];
#pragma unroll
    for (int a = 0; a < 2; ++a)
#pragma unroll
        for (int b = 0; b < 2; ++b)
#pragma unroll
            for (int m = 0; m < 4; ++m)
#pragma unroll
                for (int n = 0; n < 2; ++n) acc[a][b][m][n] = (f32x4){0.f, 0.f, 0.f, 0.f};
    bf16x8 At[4][2], B0[2][2], B1[2][2];
    const char* cA = PG8_APTR(cur); const char* cB = PG8_BPTR(cur);
    PG8_STAGE(PG8_SB(0, 0), cB, voffB); PG8_STAGE(PG8_SB(0, 1), cB + hstepB, voffB); PG8_STAGE(PG8_SA(0, 0), cA, voffA); PG8_STAGE(PG8_SA(0, 1), cA + hstepA, voffA);
    if (wr == 1) PG8_BAR;
    PG8_WAIT_V(2); PG8_BAR;
    PG8_STAGE(PG8_SB(1, 0), cB + kstep, voffB); PG8_STAGE(PG8_SA(1, 0), cA + kstep, voffA); PG8_STAGE(PG8_SB(1, 1), cB + hstepB + kstep, voffB);
    PG8_WAIT_V(6); PG8_BAR;
    for (;;) {
        const bool has_next = S.next(ui + 1, nxt);
        const char* nA = has_next ? PG8_APTR(nxt) : cA; const char* nB = has_next ? PG8_BPTR(nxt) : cB;
        const int nt = NT0 + cur.seg * (NT1 - NT0);
        for (int t = 0; t < nt; t += 2) {
            const bool last = (t == nt - 2);
            const char* a1 = cA + (size_t)(t + 1) * kstep;
            const char* a2 = last ? nA : cA + (size_t)(t + 2) * kstep; const char* b2 = last ? nB : cB + (size_t)(t + 2) * kstep;
            const char* a3 = a2 + kstep; const char* b3 = b2 + kstep;
            PG8_LDB(B0, 0, 0); PG8_LDB(B1, 0, 1); PG8_SCHED; PG8_LDA(At, 0, 0); PG8_STAGE(PG8_SA(1, 1), a1 + hstepA, voffA);
            PG8_WAIT_V(8); PG8_WAIT_L(0); PG8_BAR; PG8_MMA(0, 0, At, B0); PG8_MMA(0, 1, At, B1); PG8_BAR; PG8_SCHED;
            PG8_LDA(At, 0, 1); PG8_STAGE(PG8_SB(0, 0), b2, voffB); PG8_STAGE(PG8_SB(0, 1), b2 + hstepB, voffB); PG8_STAGE(PG8_SA(0, 0), a2, voffA);
            PG8_WAIT_V(8); PG8_WAIT_L(0); PG8_BAR; PG8_MMA(1, 0, At, B0); PG8_MMA(1, 1, At, B1); PG8_BAR; PG8_SCHED;
            PG8_LDB(B0, 1, 0); PG8_LDB(B1, 1, 1); PG8_SCHED; PG8_LDA(At, 1, 0); PG8_STAGE(PG8_SA(0, 1), a2 + hstepA, voffA);
            PG8_WAIT_V(8); PG8_WAIT_L(0); PG8_BAR; PG8_MMA(0, 0, At, B0); PG8_MMA(0, 1, At, B1); PG8_BAR; PG8_SCHED;
            PG8_LDA(At, 1, 1); PG8_STAGE(PG8_SB(1, 0), b3, voffB); PG8_STAGE(PG8_SB(1, 1), b3 + hstepB, voffB); PG8_STAGE(PG8_SA(1, 0), a3, voffA);
            PG8_WAIT_V(8); PG8_WAIT_L(0); PG8_BAR; PG8_MMA(1, 0, At, B0); PG8_MMA(1, 1, At, B1); PG8_BAR; PG8_SCHED;
        }
        if (wr == 0) PG8_BAR;
        E(acc, cur, wr, wc, fr, fq);
        if (!has_next) break;
        if (!(Epi::KEEP0 && cur.seg == 0)) {
#pragma unroll
            for (int a = 0; a < 2; ++a)
#pragma unroll
                for (int b = 0; b < 2; ++b)
#pragma unroll
                    for (int m = 0; m < 4; ++m)
#pragma unroll
                        for (int n = 0; n < 2; ++n) acc[a][b][m][n] = (f32x4){0.f, 0.f, 0.f, 0.f};
        }
        cur = nxt; cA = nA; cB = nB; ++ui;
        if (wr == 1) PG8_BAR;
    }
    PG8_WAIT_V(0);
    PG8_BAR;
#undef PG8_SA
#undef PG8_SB
#undef PG8_STAGE
#undef PG8_LDA
#undef PG8_LDB
#undef PG8_MMA
#undef PG8_WAIT_V
#undef PG8_WAIT_L
#undef PG8_BAR
#undef PG8_SCHED
#undef PG8_APTR
#undef PG8_BPTR
}

#define EPI_ROWS(ai, m) (u.pm * BM + (ai) * HALF + wr * 64 + (m) * 16 + fr)

struct EpiIn {
    static constexpr bool KEEP0 = false;
    bf16_t* U; float* out; const float* GT;
    __device__ __forceinline__ void operator()(f32x4 (&acc)[2][2][4][2], const Unit& u, int wr, int wc, int fr, int fq) const {
        const int g64 = u.pn * 4 + wc;
        const bool is_q = (g64 < 8) || (g64 >= 20 && g64 < 28);
        const bool is_k = (g64 >= 8 && g64 < 10) || (g64 >= 28 && g64 < 36);
        const bool is_norm = is_q || is_k;
        const bool is_silu = (g64 >= 12 && g64 < 20) || (g64 >= 44 && g64 < 52);
        const bool is_sig = g64 >= 52;
        const float* gp = GT + 64 * (g64 < 8 ? 0 : (g64 < 10 ? 1 : (g64 < 28 ? 2 : 3)));
        const float post = is_q ? C2 : 1.f;
        const bool kv_win = (g64 >= 8 && g64 < 12), kv_band = (g64 >= 28 && g64 < 44);
        const bool tile_has_out = (u.pm == 62 || u.pm == 63 || u.pm == 126 || u.pm == 127 || u.pm >= 128);
        f32x4 gv[2][2];
#pragma unroll
        for (int bj = 0; bj < 2; ++bj)
#pragma unroll
            for (int n = 0; n < 2; ++n) gv[bj][n] = is_norm ? *(const f32x4*)(gp + 32 * bj + 8 * fq + 4 * n) : (f32x4){1.f, 1.f, 1.f, 1.f};
#pragma unroll
        for (int ai = 0; ai < 2; ++ai)
#pragma unroll
            for (int m = 0; m < 4; ++m) {
                const int r = EPI_ROWS(ai, m);
                f32x4 v[2][2];
#pragma unroll
                for (int bj = 0; bj < 2; ++bj)
#pragma unroll
                    for (int n = 0; n < 2; ++n) v[bj][n] = acc[ai][bj][m][n];
                if (is_norm) {
                    float ss = 0.f;
#pragma unroll
                    for (int bj = 0; bj < 2; ++bj)
#pragma unroll
                        for (int n = 0; n < 2; ++n) { const f32x4 x = v[bj][n]; ss += (x[0] * x[0] + x[1] * x[1]) + (x[2] * x[2] + x[3] * x[3]); }
                    ss += __shfl_xor(ss, 16); ss += __shfl_xor(ss, 32);
                    const float rs = rsqrtf(ss * (1.f / 64.f) + EPS);
#pragma unroll
                    for (int bj = 0; bj < 2; ++bj)
#pragma unroll
                        for (int n = 0; n < 2; ++n) v[bj][n] = v[bj][n] * rs * gv[bj][n];
                } else if (is_silu) {
#pragma unroll
                    for (int bj = 0; bj < 2; ++bj)
#pragma unroll
                        for (int n = 0; n < 2; ++n)
#pragma unroll
                            for (int j = 0; j < 4; ++j) v[bj][n][j] = v[bj][n][j] * sigmoidf_(v[bj][n][j]);
                } else if (is_sig) {
#pragma unroll
                    for (int bj = 0; bj < 2; ++bj)
#pragma unroll
                        for (int n = 0; n < 2; ++n)
#pragma unroll
                            for (int j = 0; j < 4; ++j) v[bj][n][j] = fast_rcp(1.f + fast_exp2(v[bj][n][j]));
                }
                if (tile_has_out && (kv_win || kv_band)) {
                    long dst = -1;
                    if (kv_win) {
                        const int hk = (g64 - 8) & 1; const bool isv = g64 >= 10;
                        if (r < MP) { const int b = r >> 14, t = r & 16383; if (t >= 16256) dst = (long)(isv ? O_VWP : O_KWP) + ((long)(b * 128 + (t - 16256)) * 2 + hk) * 64; }
                        else { const int b = (r - MP) >> 6, i = (r - MP) & 63; dst = (long)(isv ? O_VWS : O_KWS) + ((long)(b * 128 + 64 + i) * 2 + hk) * 64; }
                    } else {
                        const int h = (g64 - 28) & 7; const bool isv = g64 >= 36;
                        if (r < MP) { const int b = r >> 14, t = r & 16383; if (t >= 15872) dst = (long)(isv ? O_VBP : O_KBP) + ((long)(b * 512 + (t - 15872)) * 8 + h) * 64; }
                        else { const int b = (r - MP) >> 6, i = (r - MP) & 63; dst = (long)(isv ? O_VBS : O_KBS) + ((long)(b * 512 + 448 + i) * 8 + h) * 64; }
                    }
                    if (dst >= 0) {
#pragma unroll
                        for (int bj = 0; bj < 2; ++bj)
#pragma unroll
                            for (int n = 0; n < 2; ++n) __builtin_nontemporal_store(v[bj][n], (f32x4*)(out + dst + 32 * bj + 8 * fq + 4 * n));
                    }
                }
                bf16_t* rowp = U + (size_t)r * LDU + g64 * 64 + 8 * fq;
#pragma unroll
                for (int bj = 0; bj < 2; ++bj) {
                    f32x4 v0 = v[bj][0], v1 = v[bj][1]; if (is_q) { v0 = v0 * post; v1 = v1 * post; }
                    u32x4 w; w.x = cvt_pk_bf16(v0[0], v0[1]); w.y = cvt_pk_bf16(v0[2], v0[3]); w.z = cvt_pk_bf16(v1[0], v1[1]); w.w = cvt_pk_bf16(v1[2], v1[3]);
                    __builtin_nontemporal_store(w, (u32x4*)(rowp + 32 * bj));
                }
            }
    }
};

struct EpiBranch {
    static constexpr bool KEEP0 = true;
    const bf16_t* U; bf16_t* Mg;
    __device__ __forceinline__ void operator()(f32x4 (&acc)[2][2][4][2], const Unit& u, int wr, int wc, int fr, int fq) const {
        const int c0 = u.pn * BM + wc * 64 + 8 * fq;
#pragma unroll
        for (int ai = 0; ai < 2; ++ai) {
            u32x4 gb[4][2], ga[4][2];
#pragma unroll
            for (int m = 0; m < 4; ++m) { const bf16_t* urow = U + (size_t)EPI_ROWS(ai, m) * LDU;
#pragma unroll
                for (int bj = 0; bj < 2; ++bj) { gb[m][bj] = *(const u32x4*)(urow + C_GB + c0 + 32 * bj); if (u.seg == 0) ga[m][bj] = *(const u32x4*)(urow + C_GA + c0 + 32 * bj); } }
            asm volatile("" ::: "memory");
#pragma unroll
            for (int m = 0; m < 4; ++m) {
                const int r = EPI_ROWS(ai, m);
#pragma unroll
                for (int bj = 0; bj < 2; ++bj) {
                    if (u.seg == 0) {
#pragma unroll
                        for (int q = 0; q < 4; ++q) {
                            const float r0 = bf_lo(ga[m][bj][q]) * fast_rcp(bf_lo(gb[m][bj][q])), r1 = bf_hi(ga[m][bj][q]) * fast_rcp(bf_hi(gb[m][bj][q]));
                            acc[ai][bj][m][q >> 1][(q & 1) * 2] *= r0; acc[ai][bj][m][q >> 1][(q & 1) * 2 + 1] *= r1;
                        }
                    } else {
                        u32x4 w;
#pragma unroll
                        for (int q = 0; q < 4; ++q) {
                            const float a0 = acc[ai][bj][m][q >> 1][(q & 1) * 2] * bf_lo(gb[m][bj][q]), a1 = acc[ai][bj][m][q >> 1][(q & 1) * 2 + 1] * bf_hi(gb[m][bj][q]);
                            w[q] = cvt_pk_bf16(a0, a1);
                        }
                        *(u32x4*)(Mg + (size_t)r * DM + c0 + 32 * bj) = w;
                    }
                }
            }
            asm volatile("" ::: "memory");
        }
    }
};

struct EpiOut {
    static constexpr bool KEEP0 = false;
    const float* xp; const float* xs; bf16_t* HP; float* SS;
    __device__ __forceinline__ void operator()(f32x4 (&acc)[2][2][4][2], const Unit& u, int wr, int wc, int fr, int fq) const {
        const int c0 = u.pn * BM + wc * 64 + 8 * fq;
        const float* xb = (u.pm < MP / BM) ? xp : (xs - (size_t)MP * DM);
#pragma unroll
        for (int ai = 0; ai < 2; ++ai) {
            f32x4 xv[4][2][2];
#pragma unroll
            for (int m = 0; m < 4; ++m) { const float* xrow = xb + (size_t)EPI_ROWS(ai, m) * DM + c0;
#pragma unroll
                for (int bj = 0; bj < 2; ++bj) { xv[m][bj][0] = __builtin_nontemporal_load((const f32x4*)(xrow + 32 * bj)); xv[m][bj][1] = __builtin_nontemporal_load((const f32x4*)(xrow + 32 * bj + 4)); } }
            asm volatile("" ::: "memory");
#pragma unroll
            for (int m = 0; m < 4; ++m) {
                const int r = EPI_ROWS(ai, m);
                float ss = 0.f;
#pragma unroll
                for (int bj = 0; bj < 2; ++bj) {
                    const f32x4 h0 = acc[ai][bj][m][0] + xv[m][bj][0], h1 = acc[ai][bj][m][1] + xv[m][bj][1];
                    ss += (h0[0] * h0[0] + h0[1] * h0[1]) + (h0[2] * h0[2] + h0[3] * h0[3]) + (h1[0] * h1[0] + h1[1] * h1[1]) + (h1[2] * h1[2] + h1[3] * h1[3]);
                    u32x4 w; w.x = cvt_pk_bf16(h0[0], h0[1]); w.y = cvt_pk_bf16(h0[2], h0[3]); w.z = cvt_pk_bf16(h1[0], h1[1]); w.w = cvt_pk_bf16(h1[2], h1[3]);
                    *(u32x4*)(HP + (size_t)r * LDHP + c0 + 32 * bj) = w;
                }
                ss += __shfl_xor(ss, 16); ss += __shfl_xor(ss, 32);
                if (fq == 0) SS[(size_t)r * 16 + u.pn * 4 + wc] = ss;
            }
            asm volatile("" ::: "memory");
        }
    }
};

struct EpiFinal {
    static constexpr bool KEEP0 = false;
    float* out; bf16_t* PLE; const float* SS; const bf16_t* HP; const LAS float* rs;
    __device__ __forceinline__ void operator()(f32x4 (&acc)[2][2][4][2], const Unit& u, int wr, int wc, int fr, int fq) const {
        const int c0 = u.pn * BM + wc * 64 + 8 * fq;
        if (u.seg == 0) {
#pragma unroll
            for (int ai = 0; ai < 2; ++ai)
#pragma unroll
                for (int m = 0; m < 4; ++m) {
                    bf16_t* prow = PLE + (size_t)EPI_ROWS(ai, m) * DM + c0;
#pragma unroll
                    for (int bj = 0; bj < 2; ++bj) {
                        const f32x4 v0 = acc[ai][bj][m][0], v1 = acc[ai][bj][m][1];
                        u32x4 w; w.x = cvt_pk_bf16(v0[0], v0[1]); w.y = cvt_pk_bf16(v0[2], v0[3]); w.z = cvt_pk_bf16(v1[0], v1[1]); w.w = cvt_pk_bf16(v1[2], v1[3]);
                        *(u32x4*)(prow + 32 * bj) = w;
                    }
                }
            return;
        }
#pragma unroll
        for (int ai = 0; ai < 2; ++ai) {
            u32x4 pw[4][2], hw[4][2]; float rstd[4];
#pragma unroll
            for (int m = 0; m < 4; ++m) { const int r = EPI_ROWS(ai, m);
#pragma unroll
                for (int bj = 0; bj < 2; ++bj) { pw[m][bj] = *(const u32x4*)(PLE + (size_t)r * DM + c0 + 32 * bj); hw[m][bj] = *(const u32x4*)(HP + (size_t)r * LDHP + c0 + 32 * bj); }
                if (rs) rstd[m] = rs[u.ti * 256 + ai * HALF + wr * 64 + m * 16 + fr];
                else { const f32x4* sp = (const f32x4*)(SS + (size_t)r * 16); const f32x4 s0 = sp[0], s1 = sp[1], s2 = sp[2], s3 = sp[3];
                    const float st = ((s0[0] + s0[1]) + (s0[2] + s0[3])) + ((s1[0] + s1[1]) + (s1[2] + s1[3])) + ((s2[0] + s2[1]) + (s2[2] + s2[3])) + ((s3[0] + s3[1]) + (s3[2] + s3[3]));
                    rstd[m] = rsqrtf(st * (1.f / DM) + EPS); } }
            asm volatile("" ::: "memory");
#pragma unroll
            for (int m = 0; m < 4; ++m) {
                float* orow = out + (size_t)EPI_ROWS(ai, m) * DM + c0;
#pragma unroll
                for (int bj = 0; bj < 2; ++bj) {
                    const f32x4 a0 = acc[ai][bj][m][0], a1 = acc[ai][bj][m][1];
                    const u32x4 p = pw[m][bj], hh = hw[m][bj];
                    f32x4 y0, y1;
                    y0[0] = bf_lo(hh[0]) + sigmoidf_(rstd[m] * a0[0]) * bf_lo(p[0]); y0[1] = bf_hi(hh[0]) + sigmoidf_(rstd[m] * a0[1]) * bf_hi(p[0]);
                    y0[2] = bf_lo(hh[1]) + sigmoidf_(rstd[m] * a0[2]) * bf_lo(p[1]); y0[3] = bf_hi(hh[1]) + sigmoidf_(rstd[m] * a0[3]) * bf_hi(p[1]);
                    y1[0] = bf_lo(hh[2]) + sigmoidf_(rstd[m] * a1[0]) * bf_lo(p[2]); y1[1] = bf_hi(hh[2]) + sigmoidf_(rstd[m] * a1[1]) * bf_hi(p[2]);
                    y1[2] = bf_lo(hh[3]) + sigmoidf_(rstd[m] * a1[2]) * bf_lo(p[3]); y1[3] = bf_hi(hh[3]) + sigmoidf_(rstd[m] * a1[3]) * bf_hi(p[3]);
                    __builtin_nontemporal_store(y0, (f32x4*)(orow + 32 * bj)); __builtin_nontemporal_store(y1, (f32x4*)(orow + 32 * bj + 4));
                }
            }
            asm volatile("" ::: "memory");
        }
    }
};
#undef EPI_ROWS
}

constexpr int RING_BYTES = 131072;
constexpr int TBL_OFF = RING_BYTES + 512;
constexpr int LDS_BYTES = 147456;
constexpr int NWAVES = 8;

__device__ __forceinline__ int crow(int r, int hi) { return (r & 3) + 8 * (r >> 2) + 4 * hi; }
typedef short v4i16_t __attribute__((ext_vector_type(4)));
__device__ __forceinline__ s16x4 vtr(const LAS unsigned char* p) { return __builtin_bit_cast(s16x4, __builtin_amdgcn_ds_read_tr16_b64_v4i16((LAS v4i16_t*)p)); }

template <bool WIN>
__device__ __forceinline__ void attn_item(bf16_t* U, const float* sink, int ci, int h, LAS unsigned char* wl, const LAS float* tbl, int lane_in) {
    constexpr int NB = WIN ? 2 : 8, NS = 2 * (NB + 1);
    int lane = lane_in; asm volatile("" : "+v"(lane));
    const int r32 = lane & 31, hi = lane >> 5;
    const bool samp = ci >= 512; const int sb = ci - 512;
    int row0, tmin;
    if (!samp) { const int c = ci & 255; row0 = (ci >> 8) * 16384 + 64 * c; tmin = (NB - c) > 0 ? (NB - c) : 0; } else { row0 = MP + 64 * sb; tmin = 0; }
    const int qcol = WIN ? (C_QA + 64 * h) : (C_QB + 64 * h);
    const int kcol = WIN ? (C_KA + 64 * (h >> 2)) : (C_KB + 64 * h);
    const int vcol = WIN ? (C_VA + 64 * (h >> 2)) : (C_VB + 64 * h);
    const int zcol = WIN ? (C_ZA + 64 * h) : (C_ZB + 64 * h);
    unsigned koff[4], voff[4];
#pragma unroll
    for (int i = 0; i < 4; ++i) { const int key = 8 * i + (lane >> 3), ch = (lane & 7) ^ ((key >> 1) & 7); koff[i] = (unsigned)(key * LDU + kcol + ch * 8); }
#pragma unroll
    for (int i = 0; i < 4; ++i) { const int dh = i >> 1, kg = i & 1; voff[i] = (unsigned)((16 * kg + (lane >> 2)) * LDU + vcol + 32 * dh + 8 * (lane & 3)); }
#define ATT_KROW(s_) ((((samp) && ((s_) >> 1) < NB) ? (CACHE_ROW0 + 512 * sb + 512 - 64 * (NB - ((s_) >> 1))) : (row0 - 64 * (NB - ((s_) >> 1)))) + 32 * ((s_) & 1))
#define ATT_DMA(s_) do { const bf16_t* kb_ = U + (size_t)ATT_KROW(s_) * LDU; LAS unsigned char* wb_ = wl + ((s_) & 1) * 8192; \
        _Pragma("unroll") for (int i_ = 0; i_ < 4; ++i_) __builtin_amdgcn_global_load_lds((const unsigned*)(kb_ + koff[i_]), (LAS unsigned*)(wb_ + i_ * 1024), 16, 0, 0); \
        _Pragma("unroll") for (int i_ = 0; i_ < 4; ++i_) __builtin_amdgcn_global_load_lds((const unsigned*)(kb_ + voff[i_]), (LAS unsigned*)(wb_ + 4096 + i_ * 1024), 16, 0, 0); } while (0)
    const int smin = 2 * tmin;
    asm volatile("s_waitcnt lgkmcnt(0)" ::: "memory");
    ATT_DMA(smin); ATT_DMA(smin + 1);
    bf16x8 qr[2][4];
#pragma unroll
    for (int qh = 0; qh < 2; ++qh)
#pragma unroll
        for (int d0 = 0; d0 < 4; ++d0) qr[qh][d0] = *(const bf16x8*)(U + (size_t)(row0 + 32 * qh + r32) * LDU + qcol + 16 * d0 + 8 * hi);
    u32x2 zr[2][2][4];
#pragma unroll
    for (int qh = 0; qh < 2; ++qh)
#pragma unroll
        for (int dh = 0; dh < 2; ++dh)
#pragma unroll
            for (int g = 0; g < 4; ++g) zr[qh][dh][g] = *(const u32x2*)(U + (size_t)(row0 + 32 * qh + r32) * LDU + 4 * hi + zcol + 32 * dh + 8 * g);
    f32x16 o[2][2];
#pragma unroll
    for (int a = 0; a < 2; ++a)
#pragma unroll
        for (int b = 0; b < 2; ++b)
#pragma unroll
            for (int r = 0; r < 16; ++r) o[a][b][r] = 0.f;
    float lrun[2];
    const float slope2 = WIN ? (LOG2E * __builtin_amdgcn_exp2f(-(float)(h + 1))) : 0.f;
    if (WIN) { lrun[0] = hi == 0 ? fast_exp2(sink[h] * LOG2E) : 0.f; lrun[1] = lrun[0]; }
    else { lrun[0] = 0.f; lrun[1] = 0.f; }
    const LAS float* th = tbl + h * 257;
    int kfo[4];
#pragma unroll
    for (int d0 = 0; d0 < 4; ++d0) kfo[d0] = r32 * 128 + (((2 * d0 + hi) ^ ((r32 >> 1) & 7)) * 16);
    const int vfo = 4096 + ((lane >> 4) & 1) * 32 + (lane & 3) * 8 + (4 * hi + ((lane & 15) >> 2)) * 64;
#pragma unroll 1
    for (int s = smin; s < NS; ++s) {
        if (s + 1 < NS) asm volatile("s_waitcnt vmcnt(8)" ::: "memory"); else asm volatile("s_waitcnt vmcnt(0)" ::: "memory");
        const LAS unsigned char* wb = wl + (s & 1) * 8192;
        f32x16 Cq[2];
#pragma unroll
        for (int qh = 0; qh < 2; ++qh) {
            f32x16 C0;
            const int iq = 32 * qh + r32;
            const float nm = -slope2 * (float)(128 + iq);
            if (WIN) {
                if (s < 4) { const float b0 = slope2 * (float)(32 * s + 4 * hi) + nm;
#pragma unroll
                    for (int r = 0; r < 16; ++r) C0[r] = __builtin_fmaf(slope2, (float)((r & 3) + 8 * (r >> 2)), b0);
                } else { const int base = 128 + iq - 32 * s - 4 * hi; const float b1 = slope2 * (float)(128 + iq) + nm;
#pragma unroll
                    for (int r = 0; r < 16; ++r) { const int cr = (r & 3) + 8 * (r >> 2); C0[r] = __builtin_fmaf(-slope2, fabsf((float)(base - cr)), b1); } }
            } else {
                if (s < 12) {
#pragma unroll
                    for (int r = 0; r < 16; ++r) C0[r] = 0.f;
                } else {
                    const int base = 512 + iq - 32 * s - 4 * hi + 128;
#pragma unroll
                    for (int r = 0; r < 16; ++r) { const int cr = (r & 3) + 8 * (r >> 2); int i0 = base - cr; i0 = i0 > 256 ? 256 : i0; C0[r] = th[i0]; }
                }
            }
            Cq[qh] = C0;
        }
        {
            bf16x8 kf[4];
#pragma unroll
            for (int d0 = 0; d0 < 4; ++d0) kf[d0] = *(const LAS bf16x8*)(wb + kfo[d0]);
            asm volatile("s_waitcnt lgkmcnt(0)" ::: "memory");
            __builtin_amdgcn_sched_barrier(0);
#pragma unroll
            for (int d0 = 0; d0 < 4; ++d0) {
                Cq[0] = __builtin_amdgcn_mfma_f32_32x32x16_bf16(kf[d0], qr[0][d0], Cq[0], 0, 0, 0);
                Cq[1] = __builtin_amdgcn_mfma_f32_32x32x16_bf16(kf[d0], qr[1][d0], Cq[1], 0, 0, 0);
            }
        }
        __builtin_amdgcn_sched_barrier(0);
        bf16x8 vf[2][2];
        { s16x4 tl[4], tu[4];
            const unsigned va = (unsigned)(uintptr_t)(wb + vfo);
            asm volatile("ds_read_b64_tr_b16 %0, %8\n\tds_read_b64_tr_b16 %1, %8 offset:512\n\tds_read_b64_tr_b16 %2, %8 offset:1024\n\tds_read_b64_tr_b16 %3, %8 offset:1536\n\t"
                         "ds_read_b64_tr_b16 %4, %8 offset:2048\n\tds_read_b64_tr_b16 %5, %8 offset:2560\n\tds_read_b64_tr_b16 %6, %8 offset:3072\n\tds_read_b64_tr_b16 %7, %8 offset:3584\n\t"
                         "s_waitcnt lgkmcnt(0)"
                         : "=&v"(tl[0]), "=&v"(tu[0]), "=&v"(tl[1]), "=&v"(tu[1]), "=&v"(tl[2]), "=&v"(tu[2]), "=&v"(tl[3]), "=&v"(tu[3]) : "v"(va) : "memory");
#pragma unroll
            for (int i = 0; i < 4; ++i) vf[i >> 1][i & 1] = (bf16x8){tl[i][0], tl[i][1], tl[i][2], tl[i][3], tu[i][0], tu[i][1], tu[i][2], tu[i][3]}; }
        if (s + 2 < NS) ATT_DMA(s + 2);
#pragma unroll
        for (int qh = 0; qh < 2; ++qh) {
            f32x16 C0 = Cq[qh];
            typedef float f32x2v __attribute__((ext_vector_type(2)));
            f32x2v ps2 = (f32x2v){0.f, 0.f};
#pragma unroll
            for (int r = 0; r < 16; r += 2) { C0[r] = fast_exp2(C0[r]); C0[r + 1] = fast_exp2(C0[r + 1]); ps2 += (f32x2v){C0[r], C0[r + 1]}; }
            lrun[qh] += ps2.x + ps2.y;
            u32x4 w0, w1;
#pragma unroll
            for (int q = 0; q < 4; ++q) { w0[q] = cvt_pk_bf16(C0[2 * q], C0[2 * q + 1]); w1[q] = cvt_pk_bf16(C0[8 + 2 * q], C0[8 + 2 * q + 1]); }
            const bf16x8 pw0 = __builtin_bit_cast(bf16x8, w0), pw1 = __builtin_bit_cast(bf16x8, w1);
#pragma unroll
            for (int dh = 0; dh < 2; ++dh) {
                o[qh][dh] = __builtin_amdgcn_mfma_f32_32x32x16_bf16(vf[dh][0], pw0, o[qh][dh], 0, 0, 0);
                o[qh][dh] = __builtin_amdgcn_mfma_f32_32x32x16_bf16(vf[dh][1], pw1, o[qh][dh], 0, 0, 0);
            }
        }
    }
#undef ATT_DMA
#undef ATT_KROW
#pragma unroll
    for (int qh = 0; qh < 2; ++qh) {
        const float lt = lrun[qh] + __shfl_xor(lrun[qh], 32);
        const float inv = 1.f / lt;
        bf16_t* rowp = U + (size_t)(row0 + 32 * qh + r32) * LDU + 8 * hi;
#pragma unroll
        for (int dh = 0; dh < 2; ++dh)
#pragma unroll
            for (int k = 0; k < 2; ++k) {
                u32x2 w[2];
#pragma unroll
                for (int e = 0; e < 2; ++e) { const int g = 2 * k + e; const u32x2 z = zr[qh][dh][g];
                    w[e].x = cvt_pk_bf16(o[qh][dh][4 * g] * inv * bf_lo(z.x), o[qh][dh][4 * g + 1] * inv * bf_hi(z.x));
                    w[e].y = cvt_pk_bf16(o[qh][dh][4 * g + 2] * inv * bf_lo(z.y), o[qh][dh][4 * g + 3] * inv * bf_hi(z.y)); }
                const auto sx = __builtin_amdgcn_permlane32_swap(w[0].x, w[1].x, false, false);
                const auto sy = __builtin_amdgcn_permlane32_swap(w[0].y, w[1].y, false, false);
                u32x4 ww; ww.x = sx[0]; ww.y = sy[0]; ww.z = sx[1]; ww.w = sy[1];
                *(u32x4*)(rowp + qcol + 32 * dh + 16 * k) = ww;
            }
    }
}

__device__ __forceinline__ unsigned f2bf(float f) { unsigned u = __builtin_bit_cast(unsigned, f); return (u + 0x7fffu + ((u >> 16) & 1u)) >> 16; }
__device__ __forceinline__ unsigned pk2(float lo, float hi) { return f2bf(lo) | (f2bf(hi) << 16); }
__device__ __forceinline__ int permrow(int n) { return (n & ~255) | ((((n >> 5) & 1) * 128) + (((n >> 6) & 3) * 32) + (n & 31)); }
__device__ __forceinline__ void p0_transpose_item(const float* W, int N, bf16_t* WT, int ldt, int col_off, const float* kscale, LAS float* scr, int item, int lane, int nscale_from = -1) {
    const int nblk = N / 32, kb = item / nblk, nb = item % nblk, k0 = 64 * kb, n0 = 32 * nb;
#pragma unroll 16
    for (int i = 0; i < 32; ++i) { const int kk = 2 * i + (lane >> 5); const float s = (kscale ? kscale[k0 + kk] : 1.f) * ((nscale_from >= 0 && n0 >= nscale_from) ? -LOG2E : 1.f); scr[kk * 33 + (lane & 31)] = __builtin_nontemporal_load(W + (size_t)(k0 + kk) * N + n0 + (lane & 31)) * s; }
    asm volatile("s_waitcnt lgkmcnt(0)" ::: "memory");
    const int c = lane & 7;
#pragma unroll
    for (int j = 0; j < 4; ++j) { const int n = (lane >> 3) + 8 * j; const LAS float* s = scr + (8 * c) * 33 + n;
        u32x4 o; o.x = pk2(s[0 * 33], s[1 * 33]); o.y = pk2(s[2 * 33], s[3 * 33]); o.z = pk2(s[4 * 33], s[5 * 33]); o.w = pk2(s[6 * 33], s[7 * 33]);
        *(u32x4*)(WT + (size_t)permrow(n0 + n) * ldt + col_off + k0 + 8 * c) = o; }
    asm volatile("s_waitcnt lgkmcnt(0)" ::: "memory");
}


#define XB_TMO      128
#define XB_XCNT(j)  (256  + 64 * (j))
#define XB_XSUB(j)  (1280 + 64 * (j))
#define XB_XGEN(j)  (2304 + 64 * (j))
#define XB_TOP      3328
#define XB_TOPGEN   3392
#define XCD_BAR_WORDS 3456
#define XB_SPIN_CAP (1u << 18)
__device__ __forceinline__ unsigned xb_ld(unsigned* p)              { return __hip_atomic_load(p, __ATOMIC_RELAXED, __HIP_MEMORY_SCOPE_AGENT); }
__device__ __forceinline__ unsigned xb_add(unsigned* p, unsigned v) { return __hip_atomic_fetch_add(p, v, __ATOMIC_RELAXED, __HIP_MEMORY_SCOPE_AGENT); }
__device__ __forceinline__ unsigned xb_xcc_id() { return (unsigned)__builtin_amdgcn_s_getreg((3 << 11) | 20) & 0xFu; }
#define XB_SPIN(cond, bar) do { unsigned _sp = 0; while (cond) { __builtin_amdgcn_s_sleep(1); \
    if ((++_sp & 255u) == 0u) { if (xb_ld(&(bar)[XB_TMO])) break; if (_sp > XB_SPIN_CAP) { atomicAdd(&(bar)[XB_TMO], 1u); break; } } } } while (0)
struct XcdBarrier { unsigned* bar; unsigned x; volatile LAS unsigned* st; };
__device__ __forceinline__ XcdBarrier xcd_barrier_post(unsigned* bar, volatile LAS unsigned* st) {
    XcdBarrier b; b.bar = bar; b.x = xb_xcc_id(); b.st = st;
    if (threadIdx.x == 0) (void)xb_add(&bar[XB_XCNT(b.x)], 1u);
    return b;
}
__device__ __forceinline__ void xcd_barrier_complete(unsigned* bar, unsigned x, unsigned& nloc, unsigned& nx) {
    const unsigned G = gridDim.x * gridDim.y * gridDim.z;
    unsigned sum, cnt, mine, sp = 0u;
    for (;;) {
        sum = 0u; cnt = 0u; mine = 0u;
#pragma unroll
        for (unsigned j = 0; j < 16; ++j) { const unsigned c = xb_ld(&bar[XB_XCNT(j)]); sum += c; cnt += (c > 0u) ? 1u : 0u; mine = (j == x) ? c : mine; }
        if (sum == G) break;
        __builtin_amdgcn_s_sleep(1);
        if ((++sp & 255u) == 0u) { if (xb_ld(&bar[XB_TMO])) break; if (sp > XB_SPIN_CAP) { atomicAdd(&bar[XB_TMO], 1u); break; } }
    }
    nloc = mine > 0u ? mine : 1u; nx = cnt > 0u ? cnt : 1u;
}
__device__ __forceinline__ void xcd_barrier(const XcdBarrier& b) {
    asm volatile("s_waitcnt vmcnt(0)" ::: "memory");
    __syncthreads();
    if (threadIdx.x == 0) {
        unsigned* bar = b.bar;
        __builtin_amdgcn_s_waitcnt(0);
        unsigned nloc = b.st[0], nx = b.st[1];
        if (nloc == 0u) { xcd_barrier_complete(bar, b.x, nloc, nx); b.st[0] = nloc; b.st[1] = nx; }
        const unsigned old = xb_add(&bar[XB_XSUB(b.x)], 1u);
        const unsigned gen = old / nloc;
        if (old + 1u == (gen + 1u) * nloc) {
            __builtin_amdgcn_fence(__ATOMIC_RELEASE, "agent");
            asm volatile("s_waitcnt vmcnt(0)" ::: "memory");
            const unsigned og = xb_add(&bar[XB_TOP], 1u);
            const unsigned tg = og / nx;
            if (og + 1u == (tg + 1u) * nx) xb_add(&bar[XB_TOPGEN], 1u);
            else XB_SPIN(xb_ld(&bar[XB_TOPGEN]) == tg, bar);
            __builtin_amdgcn_fence(__ATOMIC_ACQUIRE, "agent");
            xb_add(&bar[XB_XGEN(b.x)], 1u);
            asm volatile("s_waitcnt vmcnt(0)" ::: "memory");
        } else {
            XB_SPIN(xb_ld(&bar[XB_XGEN(b.x)]) == gen, bar);
            __builtin_amdgcn_fence(__ATOMIC_ACQUIRE, "agent");
            asm volatile("s_waitcnt vmcnt(0)" ::: "memory");
        }
    }
    __syncthreads();
}

template <int KSTEPS>
__device__ __forceinline__ void tail_partial(const bf16_t* A, int lda, const bf16_t* Bt, int ldb, int col0, LAS float* part, int lane) {
    const int fr = lane & 15, fq = lane >> 4;
    f32x4 acc[2][4];
#pragma unroll
    for (int m = 0; m < 2; ++m)
#pragma unroll
        for (int n = 0; n < 4; ++n) acc[m][n] = (f32x4){0.f, 0.f, 0.f, 0.f};
    const bf16_t* ap = A + (size_t)fr * lda + 8 * fq;
    const bf16_t* bp[4];
#pragma unroll
    for (int n = 0; n < 4; ++n) bp[n] = Bt + (size_t)permrow(col0 + 16 * n + fr) * ldb + 8 * fq;
#pragma unroll
    for (int ks = 0; ks < KSTEPS; ++ks) {
        bf16x8 a[2], b[4];
#pragma unroll
        for (int m = 0; m < 2; ++m) a[m] = *(const bf16x8*)(ap + (size_t)(16 * m) * lda + 32 * ks);
#pragma unroll
        for (int n = 0; n < 4; ++n) b[n] = *(const bf16x8*)(bp[n] + 32 * ks);
#pragma unroll
        for (int m = 0; m < 2; ++m)
#pragma unroll
            for (int n = 0; n < 4; ++n) acc[m][n] = __builtin_amdgcn_mfma_f32_16x16x32_bf16(b[n], a[m], acc[m][n], 0, 0, 0);
    }
#pragma unroll
    for (int m = 0; m < 2; ++m)
#pragma unroll
        for (int n = 0; n < 4; ++n) *(LAS f32x4*)(part + (16 * m + fr) * 64 + 16 * n + 4 * fq) = acc[m][n];
}
__device__ __forceinline__ f32x4 tail_sum(const LAS float* parts, int w0, int w1, int tid) {
    f32x4 s = (f32x4){0.f, 0.f, 0.f, 0.f};
    for (int w = w0; w < w1; ++w) s += *(const LAS f32x4*)(parts + w * 2048 + tid * 4);
    return s;
}

__device__ __forceinline__ int fresh_tid() { int t = threadIdx.x; asm volatile("" : "+v"(t)); return t; }

struct Args {
    const float* in[22]; float* out; unsigned char* ws;
};

__global__ void __launch_bounds__(NWAVES * 64, 2) fwd_megakernel(Args args) {
    extern __shared__ __attribute__((aligned(16))) unsigned char lds_raw[];
    LAS unsigned char* lds = (LAS unsigned char*)lds_raw;
    const int G = gridDim.x, bx = blockIdx.x;
    const int NGW = G * NWAVES;
#define PHASE_IDS() const int tid = fresh_tid(), lane = tid & 63, wave = __builtin_amdgcn_readfirstlane(tid >> 6), gw = bx * NWAVES + wave; (void)lane; (void)gw
    unsigned char* ws = args.ws;
    volatile LAS unsigned* bar_st = (volatile LAS unsigned*)(lds + RING_BYTES + 32);
    unsigned* bar_words = (unsigned*)ws;
    if (threadIdx.x < 2) bar_st[threadIdx.x] = 0u;
    __syncthreads();
    const XcdBarrier xbar = xcd_barrier_post(bar_words, bar_st);
    const float* x_prompt = args.in[0]; const float* x_sample = args.in[1];
    const float* ck_win = args.in[2]; const float* cv_win = args.in[3]; const float* ck_band = args.in[4]; const float* cv_band = args.in[5];
    const float* p_prompt = args.in[6]; const float* p_sample = args.in[7];
    const float* g_in = args.in[8]; const float* w_in = args.in[9]; const float* g_q_win = args.in[10]; const float* g_k_win = args.in[11];
    const float* sink_win = args.in[12]; const float* g_q_band = args.in[13]; const float* g_k_band = args.in[14]; const float* rel_bias = args.in[15];
    const float* w_o_win = args.in[16]; const float* w_o_band = args.in[17]; const float* w_out = args.in[18]; const float* g_ple = args.in[19];
    const float* w_ple_gate = args.in[20]; const float* w_ple = args.in[21];
    float* out = args.out;
    bf16_t* Win_t = (bf16_t*)(ws + WS_WIN); bf16_t* WO_t = (bf16_t*)(ws + WS_WO); bf16_t* Wout_t = (bf16_t*)(ws + WS_WOUT); bf16_t* WGP_t = (bf16_t*)(ws + WS_WGP);
    float* SS = (float*)(ws + WS_SS); bf16_t* R1 = (bf16_t*)(ws + WS_R1); bf16_t* U = (bf16_t*)(ws + WS_U); bf16_t* HP = (bf16_t*)(ws + WS_U);

    {
        PHASE_IDS();
        LAS float* scr = (LAS float*)(lds + wave * 16384);
        constexpr int I_IN = 16 * (NIN / 32);
        for (int it = gw; it < I_IN; it += NGW) p0_transpose_item(w_in, NIN, Win_t, 1024, 0, g_in, scr, it, lane, C_GA);
        if (gw == 0) { float* GT = (float*)(ws + WS_GT); GT[lane] = g_q_win[lane]; GT[64 + lane] = g_k_win[lane]; GT[128 + lane] = g_q_band[lane]; GT[192 + lane] = g_k_band[lane]; }
        for (int m0 = gw * 4; m0 < MP; m0 += NGW * 4) {
            f32x4 v[4][4]; float s2[4];
#pragma unroll
            for (int q = 0; q < 4; ++q) {
                const int m = m0 + q;
                const float* xrow = (m < MP) ? (x_prompt + (size_t)m * DM) : (x_sample + (size_t)(m - MP) * DM);
                const f32x4* xr = (const f32x4*)xrow + lane;
#pragma unroll
                for (int j = 0; j < 4; ++j) v[q][j] = __builtin_nontemporal_load(xr + 64 * j);
            }
#pragma unroll
            for (int q = 0; q < 4; ++q) { s2[q] = 0.f;
#pragma unroll
                for (int j = 0; j < 4; ++j) s2[q] += (v[q][j][0] * v[q][j][0] + v[q][j][1] * v[q][j][1]) + (v[q][j][2] * v[q][j][2] + v[q][j][3] * v[q][j][3]); }
#pragma unroll
            for (int q = 0; q < 4; ++q) {
                const float rstd = rsqrtf(wave_sum(s2[q]) * (1.f / DM) + EPS);
                u32x2* o8 = (u32x2*)(R1 + (size_t)(m0 + q) * DM) + lane;
#pragma unroll
                for (int j = 0; j < 4; ++j) { u32x2 w; w.x = pk2(v[q][j][0] * rstd, v[q][j][1] * rstd); w.y = pk2(v[q][j][2] * rstd, v[q][j][3] * rstd); o8[64 * j] = w; }
            }
        }
        for (int m = MP + gw; m < M; m += NGW) {
            const f32x4* xr = (const f32x4*)(x_sample + (size_t)(m - MP) * DM) + lane;
            f32x4 v[4]; float s2 = 0.f;
#pragma unroll
            for (int j = 0; j < 4; ++j) { v[j] = __builtin_nontemporal_load(xr + 64 * j); s2 += (v[j][0] * v[j][0] + v[j][1] * v[j][1]) + (v[j][2] * v[j][2] + v[j][3] * v[j][3]); }
            const float rstd = rsqrtf(wave_sum(s2) * (1.f / DM) + EPS);
            u32x2* o8 = (u32x2*)(R1 + (size_t)m * DM) + lane;
#pragma unroll
            for (int j = 0; j < 4; ++j) { u32x2 w; w.x = pk2(v[j][0] * rstd, v[j][1] * rstd); w.y = pk2(v[j][2] * rstd, v[j][3] * rstd); o8[64 * j] = w; }
        }
    }
    xcd_barrier(xbar);

    for (int rep = 0; rep < (PROBE_MODE == 1 ? 2 : 1); ++rep) {
    {
        pg8::Gemm g{R1, Win_t, DM, DM};
        pg8::StaticOrder S; S.init(M, NIN, G, bx, 1);
        pg8::EpiIn E{U, out, (const float*)(ws + WS_GT)};
        pg8::gemm_phase<pg8::EpiIn, 0, 0, 16, 0, 0, 16>(lds, g, S, E, fresh_tid());
        {
            PHASE_IDS();
            const int nwg_ = (M / 256) * (NIN / 256), idle0 = nwg_ % G;
            const bool use_idle = (idle0 != 0) && (G - idle0 >= 32);
            const int dw0 = use_idle ? idle0 : 0, dnw = use_idle ? (G - idle0) : G, dwb = bx - dw0;
            if (bx >= dw0) {
                LAS float* scr = (LAS float*)(lds + wave * 16384);
                constexpr int I_OW = 8 * 32, I_OUT = 16 * 32, I_G = 16 * 32, I_P = 4 * 32, NDEF = 2 * I_OW + I_OUT + I_G + I_P;
                for (int it = dwb * NWAVES + wave; it < NDEF; it += dnw * NWAVES) {
                    int r = it;
                    if (r < I_OW) { p0_transpose_item(w_o_win, DM, WO_t, 1024, 0, nullptr, scr, r, lane); continue; } r -= I_OW;
                    if (r < I_OW) { p0_transpose_item(w_o_band, DM, WO_t, 1024, 512, nullptr, scr, r, lane); continue; } r -= I_OW;
                    if (r < I_OUT) { p0_transpose_item(w_out, DM, Wout_t, 1024, 0, nullptr, scr, r, lane); continue; } r -= I_OUT;
                    if (r < I_G) { p0_transpose_item(w_ple_gate, DM, WGP_t, LDHP, 0, g_ple, scr, r, lane); continue; } r -= I_G;
                    p0_transpose_item(w_ple, DM, WGP_t, LDHP, 1024, nullptr, scr, r, lane);
                }
                const int gt = dwb * (NWAVES * 64) + tid, NGT = dnw * NWAVES * 64;
                for (int e = gt; e < 8 * 128 * 128 / 4; e += NGT) {
                    const int b = e / (128 * 32), rem = e % (128 * 32), j = rem / 32, c4 = (rem % 32) * 4;
                    const f32x4 k = __builtin_nontemporal_load((const f32x4*)(ck_win + (size_t)e * 4)), v = __builtin_nontemporal_load((const f32x4*)(cv_win + (size_t)e * 4));
                    bf16_t* urow = U + (size_t)(CACHE_ROW0 + 512 * b + 384 + j) * LDU;
                    u32x2 wk; wk.x = pk2(k[0], k[1]); wk.y = pk2(k[2], k[3]); u32x2 wv; wv.x = pk2(v[0], v[1]); wv.y = pk2(v[2], v[3]);
                    *(u32x2*)(urow + C_KA + c4) = wk; *(u32x2*)(urow + C_VA + c4) = wv;
                    if (j >= 64) { __builtin_nontemporal_store(k, (f32x4*)(out + O_KWS + ((size_t)(b * 128 + j - 64) * 128 + c4))); __builtin_nontemporal_store(v, (f32x4*)(out + O_VWS + ((size_t)(b * 128 + j - 64) * 128 + c4))); }
                }
                for (int e0 = gt; e0 < 8 * 512 * 512 / 4; e0 += 4 * NGT) {
                    f32x4 kk[4], vv[4];
#pragma unroll
                    for (int q = 0; q < 4; ++q) { const int e = e0 + q * NGT; if (e < 8 * 512 * 512 / 4) { kk[q] = __builtin_nontemporal_load((const f32x4*)(ck_band + (size_t)e * 4)); vv[q] = __builtin_nontemporal_load((const f32x4*)(cv_band + (size_t)e * 4)); } }
#pragma unroll
                    for (int q = 0; q < 4; ++q) { const int e = e0 + q * NGT; if (e < 8 * 512 * 512 / 4) {
                        const int b = e / (512 * 128), rem = e % (512 * 128), j = rem / 128, c4 = (rem % 128) * 4;
                        const f32x4 k = kk[q], v = vv[q];
                        bf16_t* urow = U + (size_t)(CACHE_ROW0 + 512 * b + j) * LDU;
                        u32x2 wk; wk.x = pk2(k[0], k[1]); wk.y = pk2(k[2], k[3]); u32x2 wv; wv.x = pk2(v[0], v[1]); wv.y = pk2(v[2], v[3]);
                        *(u32x2*)(urow + C_KB + c4) = wk; *(u32x2*)(urow + C_VB + c4) = wv;
                        if (j >= 64) { __builtin_nontemporal_store(k, (f32x4*)(out + O_KBS + ((size_t)(b * 512 + j - 64) * 512 + c4))); __builtin_nontemporal_store(v, (f32x4*)(out + O_VBS + ((size_t)(b * 512 + j - 64) * 512 + c4))); } } }
                }
            }
        }
    }
    xcd_barrier(xbar);
    }

    {
        PHASE_IDS();
        LAS float* tbl = (LAS float*)(lds + TBL_OFF);
        for (int i = tid; i < 8 * 257; i += NWAVES * 64) tbl[i] = (rel_bias[i] - rel_bias[(i / 257) * 257 + 256]) * LOG2E;
        __syncthreads();
        LAS unsigned char* wl = lds + wave * 16384;
        if (NGW == 2048) {
            const int c0 = 65 * (bx & 7), wx = (bx >> 3) * NWAVES + wave;
#pragma unroll 1
            for (int k = 0; k < 3; ++k) { const int j = wx + 256 * k; if (j < 520) attn_item<false>(U, sink_win, c0 + (j >> 3), j & 7, wl, tbl, lane); }
            if (wx >= 8) { const int w2 = wx - 8;
#pragma unroll 1
                for (int k = 0; k < 3; ++k) { const int j = w2 + 248 * k; if (k < 2 || w2 < 24) attn_item<true>(U, sink_win, c0 + (j >> 3), j & 7, wl, tbl, lane); } }
        } else {
            for (int it = gw; it < 2 * 4160; it += NGW) {
                if (it < 4160) attn_item<false>(U, sink_win, it >> 3, it & 7, wl, tbl, lane);
                else { const int j = it - 4160; attn_item<true>(U, sink_win, j >> 3, j & 7, wl, tbl, lane); }
            }
        }
        __syncthreads();
    }
    xcd_barrier(xbar);

    for (int rep = 0; rep < (PROBE_MODE == 3 ? 2 : 1); ++rep) {
    {
        if (G == 256) {
            PHASE_IDS();
            const int tm = bx >> 4, tn = bx & 15, row0 = MP + 32 * tm, col0 = 64 * tn, br = wave >> 2, kw = (wave & 3) * 128;
            LAS float* parts = (LAS float*)lds;
            tail_partial<4>(U + (size_t)row0 * LDU + (br ? C_QB : C_QA) + kw, LDU, WO_t + br * 512 + kw, DM, col0, parts + wave * 2048, lane);
            __syncthreads();
            const f32x4 ca = tail_sum(parts, 0, 4, tid), cb = tail_sum(parts, 4, 8, tid);
            const int r = row0 + (tid >> 4), c = col0 + (tid & 15) * 4;
            const u32x2 ga = *(const u32x2*)(U + (size_t)r * LDU + C_GA + c), gb = *(const u32x2*)(U + (size_t)r * LDU + C_GB + c);
            u32x2 w;
            w.x = cvt_pk_bf16(bf_lo(ga.x) * ca[0] + bf_lo(gb.x) * cb[0], bf_hi(ga.x) * ca[1] + bf_hi(gb.x) * cb[1]);
            w.y = cvt_pk_bf16(bf_lo(ga.y) * ca[2] + bf_lo(gb.y) * cb[2], bf_hi(ga.y) * ca[3] + bf_hi(gb.y) * cb[3]);
            *(u32x2*)(R1 + (size_t)r * DM + c) = w;
            __syncthreads();
        }
        pg8::Gemm g{U, WO_t, LDU, DM};
        pg8::StaticOrder S; S.init(G == 256 ? MP : M, DM, G, bx, 2);
        pg8::EpiBranch E{U, R1};
        pg8::gemm_phase<pg8::EpiBranch, C_QA, 0, 8, C_QB, 512, 8>(lds, g, S, E, fresh_tid());
    }
    xcd_barrier(xbar);
    }

    for (int rep = 0; rep < (PROBE_MODE == 3 ? 2 : 1); ++rep) {
    {
        PHASE_IDS();
        for (int m0 = gw * 4; m0 < MP; m0 += NGW * 4) {
            f32x4 v[4];
#pragma unroll
            for (int q = 0; q < 4; ++q) v[q] = __builtin_nontemporal_load((const f32x4*)(p_prompt + (size_t)(m0 + q) * 256) + lane);
#pragma unroll
            for (int q = 0; q < 4; ++q) { u32x2 w; w.x = pk2(v[q][0], v[q][1]); w.y = pk2(v[q][2], v[q][3]); *((u32x2*)(HP + (size_t)(m0 + q) * LDHP + 1024) + lane) = w; }
        }
        for (int m = MP + gw; m < M; m += NGW) {
            const f32x4 v = *((const f32x4*)(p_sample + (size_t)(m - MP) * 256) + lane);
            u32x2 w; w.x = pk2(v[0], v[1]); w.y = pk2(v[2], v[3]);
            *((u32x2*)(HP + (size_t)m * LDHP + 1024) + lane) = w;
        }
        if (G == 256) {
            const int tm = bx >> 4, tn = bx & 15, row0 = MP + 32 * tm, col0 = 64 * tn, kw = wave * 128;
            LAS float* parts = (LAS float*)lds;
            tail_partial<4>(R1 + (size_t)row0 * DM + kw, DM, Wout_t + kw, DM, col0, parts + wave * 2048, lane);
            __syncthreads();
            const f32x4 cc = tail_sum(parts, 0, 8, tid);
            const int r = row0 + (tid >> 4), c = col0 + (tid & 15) * 4;
            const f32x4 h = cc + *(const f32x4*)(x_sample + (size_t)(r - MP) * DM + c);
            u32x2 w; w.x = cvt_pk_bf16(h[0], h[1]); w.y = cvt_pk_bf16(h[2], h[3]);
            *(u32x2*)(HP + (size_t)r * LDHP + c) = w;
            float ss = (h[0] * h[0] + h[1] * h[1]) + (h[2] * h[2] + h[3] * h[3]);
            ss += __shfl_xor(ss, 1); ss += __shfl_xor(ss, 2); ss += __shfl_xor(ss, 4); ss += __shfl_xor(ss, 8);
            if ((tid & 15) == 0) SS[(size_t)r * 16 + tn] = ss;
            __syncthreads();
        }
        pg8::Gemm g{R1, Wout_t, DM, DM};
        pg8::StaticOrder S; S.init(G == 256 ? MP : M, DM, G, bx, 1);
        pg8::EpiOut E{x_prompt, x_sample, HP, SS};
        pg8::gemm_phase<pg8::EpiOut, 0, 0, 16, 0, 0, 16>(lds, g, S, E, fresh_tid());
    }
    xcd_barrier(xbar);
    }

    {
        if (G == 256) {
            PHASE_IDS();
            const int tm = bx >> 4, tn = bx & 15, row0 = MP + 32 * tm, col0 = 64 * tn;
            LAS float* parts = (LAS float*)lds;
            tail_partial<1>(HP + (size_t)row0 * LDHP + 1024 + wave * 32, LDHP, WGP_t + 1024 + wave * 32, LDHP, col0, parts + wave * 2048, lane);
            __syncthreads();
            const f32x4 ple = tail_sum(parts, 0, 8, tid);
            __syncthreads();
            tail_partial<4>(HP + (size_t)row0 * LDHP + wave * 128, LDHP, WGP_t + wave * 128, LDHP, col0, parts + wave * 2048, lane);
            __syncthreads();
            const f32x4 cc = tail_sum(parts, 0, 8, tid);
            const int r = row0 + (tid >> 4), c = col0 + (tid & 15) * 4;
            const f32x4* sp = (const f32x4*)(SS + (size_t)r * 16);
            const f32x4 s0 = sp[0], s1 = sp[1], s2 = sp[2], s3 = sp[3];
            const float st = ((s0[0] + s0[1]) + (s0[2] + s0[3])) + ((s1[0] + s1[1]) + (s1[2] + s1[3])) + ((s2[0] + s2[1]) + (s2[2] + s2[3])) + ((s3[0] + s3[1]) + (s3[2] + s3[3]));
            const float rstd = rsqrtf(st * (1.f / DM) + EPS);
            const u32x2 hw = *(const u32x2*)(HP + (size_t)r * LDHP + c);
            f32x4 y;
            y[0] = bf_lo(hw.x) + sigmoidf_(rstd * cc[0]) * ple[0]; y[1] = bf_hi(hw.x) + sigmoidf_(rstd * cc[1]) * ple[1];
            y[2] = bf_lo(hw.y) + sigmoidf_(rstd * cc[2]) * ple[2]; y[3] = bf_hi(hw.y) + sigmoidf_(rstd * cc[3]) * ple[3];
            *(f32x4*)(out + (size_t)r * DM + c) = y;
            __syncthreads();
        }
        pg8::Gemm g{HP, WGP_t, LDHP, LDHP};
        pg8::StaticOrder S; S.init(G == 256 ? MP : M, DM, G, bx, 2);
        LAS float* rs = nullptr;
        if (G == 256) {
            const int t2 = fresh_tid();
            rs = (LAS float*)(lds + TBL_OFF);
            pg8::Unit uu; if (S.next(2 * (t2 >> 8), uu)) {
                const int r = uu.pm * 256 + (t2 & 255);
                const f32x4* sp = (const f32x4*)(SS + (size_t)r * 16); const f32x4 s0 = sp[0], s1 = sp[1], s2 = sp[2], s3 = sp[3];
                const float st = ((s0[0] + s0[1]) + (s0[2] + s0[3])) + ((s1[0] + s1[1]) + (s1[2] + s1[3])) + ((s2[0] + s2[1]) + (s2[2] + s2[3])) + ((s3[0] + s3[1]) + (s3[2] + s3[3]));
                rs[t2] = rsqrtf(st * (1.f / DM) + EPS); }
            __syncthreads();
        }
        pg8::EpiFinal E{out, R1, SS, HP, rs};
        pg8::gemm_phase<pg8::EpiFinal, 1024, 1024, 4, 0, 0, 16>(lds, g, S, E, fresh_tid());
    }
}

extern "C" void kernel_launch(void* const* d_in, const int* in_sizes, int n_in, void* d_out, int out_size, void* d_ws, size_t ws_size, hipStream_t stream) {
    static int grid = 0;
    if (grid == 0) {
        if (n_in != 22 || out_size != (int)O_END || ws_size < WS_END) { fprintf(stderr, "kernel_launch: unexpected sizes n_in %d out %d ws %zu (need %zu)\n", n_in, out_size, ws_size, (size_t)WS_END); grid = -1; return; }
        int dev = 0, cus = 0, per_cu = 0;
        hipGetDevice(&dev);
        hipDeviceGetAttribute(&cus, hipDeviceAttributeMultiprocessorCount, dev);
        hipFuncSetAttribute((const void*)fwd_megakernel, hipFuncAttributeMaxDynamicSharedMemorySize, LDS_BYTES);
        hipOccupancyMaxActiveBlocksPerMultiprocessor(&per_cu, (const void*)fwd_megakernel, NWAVES * 64, LDS_BYTES);
        if (per_cu < 1) { fprintf(stderr, "kernel_launch: occupancy query says %d blocks per CU\n", per_cu); per_cu = 1; }
        grid = cus;
    }
    if (grid < 0) return;
    Args a{};
    for (int i = 0; i < 22; ++i) a.in[i] = (const float*)d_in[i];
    a.out = (float*)d_out; a.ws = (unsigned char*)d_ws;
    if (hipMemsetAsync(d_ws, 0, XCD_BAR_WORDS * sizeof(unsigned), stream) != hipSuccess) { fprintf(stderr, "kernel_launch: memset of the barrier words failed\n"); return; }
    void* kargs[] = {&a};
    hipError_t e = hipLaunchCooperativeKernel((const void*)fwd_megakernel, dim3(grid), dim3(NWAVES * 64), kargs, LDS_BYTES, stream);
    if (e != hipSuccess) fprintf(stderr, "cooperative launch failed: %s (grid %d)\n", hipGetErrorString(e), grid);
}
```

```cpp
#include <hip/hip_runtime.h>
#include <hip/hip_cooperative_groups.h>
#include <cstdio>
#include <cstdint>
namespace cg = cooperative_groups;
#ifndef PROBE_MODE
#define PROBE_MODE 0
#endif

#define LAS __attribute__((address_space(3)))
#define GAS __attribute__((address_space(1)))
typedef unsigned short bf16_t;
typedef short bf16x8 __attribute__((ext_vector_type(8)));
typedef short s16x4 __attribute__((ext_vector_type(4)));
typedef float f32x4 __attribute__((ext_vector_type(4)));
typedef float f32x16 __attribute__((ext_vector_type(16)));
typedef unsigned u32x4 __attribute__((ext_vector_type(4)));
typedef unsigned u32x2 __attribute__((ext_vector_type(2)));

constexpr int MP = 32768, MS = 512, M = MP + MS;
constexpr int DM = 1024, NIN = 5376, LDU = NIN;
constexpr int CACHE_ROW0 = M;
constexpr int UROWS = M + 8 * 512;
constexpr int LDHP = 1280;
constexpr float EPS = 1e-6f;
constexpr float LOG2E = 1.4426950408889634f;
constexpr float ATT_THR = 8.f;
constexpr float C2 = 0.125f * LOG2E;
constexpr size_t O_Y = 0, O_KWP = 34078720, O_VWP = 34111488, O_KBP = 34144256, O_VBP = 34668544,
                 O_KWS = 35192832, O_VWS = 35323904, O_KBS = 35454976, O_VBS = 37552128, O_END = 39649280;
constexpr int C_QA = 0, C_KA = 512, C_VA = 640, C_ZA = 768, C_QB = 1280, C_KB = 1792, C_VB = 2304, C_ZB = 2816, C_GA = 3328, C_GB = 4352;

constexpr size_t MiB = 1u << 20;
constexpr size_t WS_GT = 1 * MiB;
constexpr size_t WS_WIN = 2 * MiB;
constexpr size_t WS_WO = 13 * MiB;
constexpr size_t WS_WOUT = 15 * MiB;
constexpr size_t WS_WGP = 17 * MiB;
constexpr size_t WS_SS = 20 * MiB;
constexpr size_t WS_R1 = 24 * MiB;
constexpr size_t WS_U = 90 * MiB;
constexpr size_t WS_END = WS_U + (size_t)UROWS * LDU * 2;
static_assert(WS_END <= 512 * MiB, "d_ws map");

typedef float f32x2_t __attribute__((ext_vector_type(2))); typedef __bf16 bf16x2_t __attribute__((ext_vector_type(2)));
__device__ __forceinline__ unsigned cvt_pk_bf16(float lo, float hi) { const f32x2_t v = {lo, hi}; const bf16x2_t b = __builtin_convertvector(v, bf16x2_t); return __builtin_bit_cast(unsigned, b); }
__device__ __forceinline__ float bf_lo(unsigned w) { return __uint_as_float(w << 16); }
__device__ __forceinline__ float bf_hi(unsigned w) { return __uint_as_float(w & 0xffff0000u); }
__device__ __forceinline__ float fast_exp2(float x) { return __builtin_amdgcn_exp2f(x); }
__device__ __forceinline__ float fast_rcp(float x) { return __builtin_amdgcn_rcpf(x); }
__device__ __forceinline__ float sigmoidf_(float x) { return fast_rcp(1.f + fast_exp2(-LOG2E * x)); }
__device__ __forceinline__ float wave_sum(float v) {
#pragma unroll
    for (int o = 1; o < 64; o <<= 1) v += __shfl_xor(v, o);
    return v;
}

namespace pg8 {
constexpr int BM = 256, BK = 64, HALF = 128, HTB = HALF * BK * 2, STAGE_BYTES = 8 * HTB, NXCD = 8, WGM = 8;
__host__ __device__ __forceinline__ int lds_byte(int r, int c) { const int st = (r >> 4) * 2 + (c >> 5), rr = r & 15, cc = c & 31, ob = rr * 64 + cc * 2; return st * 1024 + (ob ^ (((ob >> 9) & 1) << 5)); }
__host__ __device__ __forceinline__ void stage_rc(int b, int& R, int& C) { const int st = b / 1024, sb = b % 1024, swz = sb ^ (((sb >> 9) & 1) << 5); R = (st >> 1) * 16 + swz / 64; C = (st & 1) * 32 + (swz % 64) / 2; }
__host__ __device__ __forceinline__ int perm32(int rho) { const int n = rho >> 4, i = rho & 15; return 8 * (i >> 2) + 4 * n + (i & 3); }

struct Unit { int pm, pn, seg, ti; };
struct Gemm { const bf16_t* A; const bf16_t* Bt; int lda, ldb; };

struct StaticOrder {
    int nM, nN, nwg, G, c, nseg;
    __device__ void init(int M_, int N_, int G_, int c_, int nseg_) { nM = M_ / BM; nN = N_ / BM; nwg = nM * nN; G = G_; c = c_; nseg = nseg_; }
    __device__ bool next(int i, Unit& u) const {
        const int it = (nseg == 2) ? (i >> 1) : i;
        const long L = (long)it * G + c; if (L >= nwg) return false;
        int wgid = (int)L; { const int q = nwg / NXCD, r = nwg % NXCD, xcd = wgid % NXCD, off = wgid / NXCD; wgid = (xcd < r ? xcd * (q + 1) : r * (q + 1) + (xcd - r) * q) + off; }
        const int nig = WGM * nN, gid = wgid / nig, fm = gid * WGM, gsz = (nM - fm) < WGM ? (nM - fm) : WGM;
        u.pm = fm + ((wgid % nig) % gsz); u.pn = (wgid % nig) / gsz; u.seg = (nseg == 2) ? (i & 1) : 0; u.ti = it; return true;
    }
};

template <class Epi, int AC0, int BC0, int NT0, int AC1, int BC1, int NT1>
__device__ __forceinline__ void gemm_phase(LAS unsigned char* lds, const Gemm g, const StaticOrder& S, const Epi& E, int tid) {
    const int wid = __builtin_amdgcn_readfirstlane(tid >> 6), lane = tid & 63, wr = wid >> 2, wc = wid & 3, fr = lane & 15, fq = lane >> 4;
    unsigned voffA[2], voffB[2];
#pragma unroll
    for (int i = 0; i < 2; ++i) { int R, C; stage_rc(tid * 16 + i * 8192, R, C); const int Rb = (R & ~31) + perm32(R & 31);
        voffA[i] = (unsigned)(R * g.lda + C) * 2u; voffB[i] = (unsigned)(Rb * g.ldb + C) * 2u; }
    const size_t kstep = (size_t)(BK * 2);
    const size_t hstepA = (size_t)HALF * g.lda * 2, hstepB = (size_t)HALF * g.ldb * 2;
    const unsigned ldsw = (unsigned)wid * 1024u;
    const int aoff = lds_byte(wr * 64 + fr, fq * 8), boff = lds_byte(wc * 32 + fr, fq * 8);
#define PG8_SA(b, h) (((b) * 2 + (h)) * HTB)
#define PG8_SB(b, h) ((4 + (b) * 2 + (h)) * HTB)
#define PG8_STAGE(bufoff, gbase, voff) do { _Pragma("unroll") for (int _i = 0; _i < 2; ++_i) \
        __builtin_amdgcn_global_load_lds((const unsigned*)((const char*)(gbase) + (voff)[_i]), (LAS unsigned*)(lds + (bufoff) + ldsw + _i * 8192), 16, 0, 0); } while (0)
#define PG8_LDA(dst, b, h) do { _Pragma("unroll") for (int m = 0; m < 4; ++m) _Pragma("unroll") for (int k = 0; k < 2; ++k) dst[m][k] = *(const LAS bf16x8*)(lds + PG8_SA(b, h) + aoff + m * 2048 + k * 1024); } while (0)
#define PG8_LDB(dst, b, h) do { _Pragma("unroll") for (int n = 0; n < 2; ++n) _Pragma("unroll") for (int k = 0; k < 2; ++k) dst[n][k] = *(const LAS bf16x8*)(lds + PG8_SB(b, h) + boff + n * 2048 + k * 1024); } while (0)
#define PG8_MMA(ai, bj, At, Bt) do { __builtin_amdgcn_s_setprio(1); _Pragma("unroll") for (int m = 0; m < 4; ++m) _Pragma("unroll") for (int n = 0; n < 2; ++n) _Pragma("unroll") for (int k = 0; k < 2; ++k) \
        acc[ai][bj][m][n] = __builtin_amdgcn_mfma_f32_16x16x32_bf16(Bt[n][k], At[m][k], acc[ai][bj][m][n], 0, 0, 0); __builtin_amdgcn_s_setprio(0); } while (0)
#define PG8_WAIT_V(n) asm volatile("s_waitcnt vmcnt(" #n ")" ::: "memory")
#define PG8_WAIT_L(n) asm volatile("s_waitcnt lgkmcnt(" #n ")" ::: "memory")
#define PG8_BAR __builtin_amdgcn_s_barrier()
#define PG8_SCHED __builtin_amdgcn_sched_barrier(0)
#define PG8_APTR(u) ((const char*)g.A + ((size_t)(u).pm * 2 * hstepA + (size_t)(AC0 + (u).seg * (AC1 - AC0)) * 2))
#define PG8_BPTR(u) ((const char*)g.Bt + ((size_t)(u).pn * 2 * hstepB + (size_t)(BC0 + (u).seg * (BC1 - BC0)) * 2))
    Unit cur, nxt; int ui = 0;
    if (!S.next(0, cur)) return;
    f32x4 acc[2][2][4][2];
#pragma unroll
    for (int a = 0; a < 2; ++a)
#pragma unroll
        for (int b = 0; b < 2; ++b)
#pragma unroll
            for (int m = 0; m < 4; ++m)
#pragma unroll
                for (int n = 0; n < 2; ++n) acc[a][b][m][n] = (f32x4){0.f, 0.f, 0.f, 0.f};
    bf16x8 At[4][2], B0[2][2], B1[2][2];
    const char* cA = PG8_APTR(cur); const char* cB = PG8_BPTR(cur);
    PG8_STAGE(PG8_SB(0, 0), cB, voffB); PG8_STAGE(PG8_SB(0, 1), cB + hstepB, voffB); PG8_STAGE(PG8_SA(0, 0), cA, voffA); PG8_STAGE(PG8_SA(0, 1), cA + hstepA, voffA);
    if (wr == 1) PG8_BAR;
    PG8_WAIT_V(2); PG8_BAR;
    PG8_STAGE(PG8_SB(1, 0), cB + kstep, voffB); PG8_STAGE(PG8_SA(1, 0), cA + kstep, voffA); PG8_STAGE(PG8_SB(1, 1), cB + hstepB + kstep, voffB);
    PG8_WAIT_V(6); PG8_BAR;
    for (;;) {
        const bool has_next = S.next(ui + 1, nxt);
        const char* nA = has_next ? PG8_APTR(nxt) : cA; const char* nB = has_next ? PG8_BPTR(nxt) : cB;
        const int nt = NT0 + cur.seg * (NT1 - NT0);
        for (int t = 0; t < nt; t += 2) {
            const bool last = (t == nt - 2);
            const char* a1 = cA + (size_t)(t + 1) * kstep;
            const char* a2 = last ? nA : cA + (size_t)(t + 2) * kstep; const char* b2 = last ? nB : cB + (size_t)(t + 2) * kstep;
            const char* a3 = a2 + kstep; const char* b3 = b2 + kstep;
            PG8_LDB(B0, 0, 0); PG8_LDB(B1, 0, 1); PG8_SCHED; PG8_LDA(At, 0, 0); PG8_STAGE(PG8_SA(1, 1), a1 + hstepA, voffA);
            PG8_WAIT_V(8); PG8_WAIT_L(0); PG8_BAR; PG8_MMA(0, 0, At, B0); PG8_MMA(0, 1, At, B1); PG8_BAR; PG8_SCHED;
            PG8_LDA(At, 0, 1); PG8_STAGE(PG8_SB(0, 0), b2, voffB); PG8_STAGE(PG8_SB(0, 1), b2 + hstepB, voffB); PG8_STAGE(PG8_SA(0, 0), a2, voffA);
            PG8_WAIT_V(8); PG8_WAIT_L(0); PG8_BAR; PG8_MMA(1, 0, At, B0); PG8_MMA(1, 1, At, B1); PG8_BAR; PG8_SCHED;
            PG8_LDB(B0, 1, 0); PG8_LDB(B1, 1, 1); PG8_SCHED; PG8_LDA(At, 1, 0); PG8_STAGE(PG8_SA(0, 1), a2 + hstepA, voffA);
            PG8_WAIT_V(8); PG8_WAIT_L(0); PG8_BAR; PG8_MMA(0, 0, At, B0); PG8_MMA(0, 1, At, B1); PG8_BAR; PG8_SCHED;
            PG8_LDA(At, 1, 1); PG8_STAGE(PG8_SB(1, 0), b3, voffB); PG8_STAGE(PG8_SB(1, 1), b3 + hstepB, voffB); PG8_STAGE(PG8_SA(1, 0), a3, voffA);
            PG8_WAIT_V(8); PG8_WAIT_L(0); PG8_BAR; PG8_MMA(1, 0, At, B0); PG8_MMA(1, 1, At, B1); PG8_BAR; PG8_SCHED;
        }
        if (wr == 0) PG8_BAR;
        E(acc, cur, wr, wc, fr, fq);
        if (!has_next) break;
        if (!(Epi::KEEP0 && cur.seg == 0)) {
#pragma unroll
            for (int a = 0; a < 2; ++a)
#pragma unroll
                for (int b = 0; b < 2; ++b)
#pragma unroll
                    for (int m = 0; m < 4; ++m)
#pragma unroll
                        for (int n = 0; n < 2; ++n) acc[a][b][m][n] = (f32x4){0.f, 0.f, 0.f, 0.f};
        }
        cur = nxt; cA = nA; cB = nB; ++ui;
        if (wr == 1) PG8_BAR;
    }
    PG8_WAIT_V(0);
    PG8_BAR;
#undef PG8_SA
#undef PG8_SB
#undef PG8_STAGE
#undef PG8_LDA
#undef PG8_LDB
#undef PG8_MMA
#undef PG8_WAIT_V
#undef PG8_WAIT_L
#undef PG8_BAR
#undef PG8_SCHED
#undef PG8_APTR
#undef PG8_BPTR
}

#define EPI_ROWS(ai, m) (u.pm * BM + (ai) * HALF + wr * 64 + (m) * 16 + fr)

struct EpiIn {
    static constexpr bool KEEP0 = false;
    bf16_t* U; float* out; const float* GT;
    __device__ __forceinline__ void operator()(f32x4 (&acc)[2][2][4][2], const Unit& u, int wr, int wc, int fr, int fq) const {
        const int g64 = u.pn * 4 + wc;
        const bool is_q = (g64 < 8) || (g64 >= 20 && g64 < 28);
        const bool is_k = (g64 >= 8 && g64 < 10) || (g64 >= 28 && g64 < 36);
        const bool is_norm = is_q || is_k;
        const bool is_silu = (g64 >= 12 && g64 < 20) || (g64 >= 44 && g64 < 52);
        const bool is_sig = g64 >= 52;
        const float* gp = GT + 64 * (g64 < 8 ? 0 : (g64 < 10 ? 1 : (g64 < 28 ? 2 : 3)));
        const float post = is_q ? C2 : 1.f;
        const bool kv_win = (g64 >= 8 && g64 < 12), kv_band = (g64 >= 28 && g64 < 44);
        const bool tile_has_out = (u.pm == 62 || u.pm == 63 || u.pm == 126 || u.pm == 127 || u.pm >= 128);
        f32x4 gv[2][2];
#pragma unroll
        for (int bj = 0; bj < 2; ++bj)
#pragma unroll
            for (int n = 0; n < 2; ++n) gv[bj][n] = is_norm ? *(const f32x4*)(gp + 32 * bj + 8 * fq + 4 * n) : (f32x4){1.f, 1.f, 1.f, 1.f};
#pragma unroll
        for (int ai = 0; ai < 2; ++ai)
#pragma unroll
            for (int m = 0; m < 4; ++m) {
                const int r = EPI_ROWS(ai, m);
                f32x4 v[2][2];
#pragma unroll
                for (int bj = 0; bj < 2; ++bj)
#pragma unroll
                    for (int n = 0; n < 2; ++n) v[bj][n] = acc[ai][bj][m][n];
                if (is_norm) {
                    float ss = 0.f;
#pragma unroll
                    for (int bj = 0; bj < 2; ++bj)
#pragma unroll
                        for (int n = 0; n < 2; ++n) { const f32x4 x = v[bj][n]; ss += (x[0] * x[0] + x[1] * x[1]) + (x[2] * x[2] + x[3] * x[3]); }
                    ss += __shfl_xor(ss, 16); ss += __shfl_xor(ss, 32);
                    const float rs = rsqrtf(ss * (1.f / 64.f) + EPS);
#pragma unroll
                    for (int bj = 0; bj < 2; ++bj)
#pragma unroll
                        for (int n = 0; n < 2; ++n) v[bj][n] = v[bj][n] * rs * gv[bj][n];
                } else if (is_silu) {
#pragma unroll
                    for (int bj = 0; bj < 2; ++bj)
#pragma unroll
                        for (int n = 0; n < 2; ++n)
#pragma unroll
                            for (int j = 0; j < 4; ++j) v[bj][n][j] = v[bj][n][j] * sigmoidf_(v[bj][n][j]);
                } else if (is_sig) {
#pragma unroll
                    for (int bj = 0; bj < 2; ++bj)
#pragma unroll
                        for (int n = 0; n < 2; ++n)
#pragma unroll
                            for (int j = 0; j < 4; ++j) v[bj][n][j] = fast_rcp(1.f + fast_exp2(v[bj][n][j]));
                }
                if (tile_has_out && (kv_win || kv_band)) {
                    long dst = -1;
                    if (kv_win) {
                        const int hk = (g64 - 8) & 1; const bool isv = g64 >= 10;
                        if (r < MP) { const int b = r >> 14, t = r & 16383; if (t >= 16256) dst = (long)(isv ? O_VWP : O_KWP) + ((long)(b * 128 + (t - 16256)) * 2 + hk) * 64; }
                        else { const int b = (r - MP) >> 6, i = (r - MP) & 63; dst = (long)(isv ? O_VWS : O_KWS) + ((long)(b * 128 + 64 + i) * 2 + hk) * 64; }
                    } else {
                        const int h = (g64 - 28) & 7; const bool isv = g64 >= 36;
                        if (r < MP) { const int b = r >> 14, t = r & 16383; if (t >= 15872) dst = (long)(isv ? O_VBP : O_KBP) + ((long)(b * 512 + (t - 15872)) * 8 + h) * 64; }
                        else { const int b = (r - MP) >> 6, i = (r - MP) & 63; dst = (long)(isv ? O_VBS : O_KBS) + ((long)(b * 512 + 448 + i) * 8 + h) * 64; }
                    }
                    if (dst >= 0) {
#pragma unroll
                        for (int bj = 0; bj < 2; ++bj)
#pragma unroll
                            for (int n = 0; n < 2; ++n) __builtin_nontemporal_store(v[bj][n], (f32x4*)(out + dst + 32 * bj + 8 * fq + 4 * n));
                    }
                }
                bf16_t* rowp = U + (size_t)r * LDU + g64 * 64 + 8 * fq;
#pragma unroll
                for (int bj = 0; bj < 2; ++bj) {
                    f32x4 v0 = v[bj][0], v1 = v[bj][1]; if (is_q) { v0 = v0 * post; v1 = v1 * post; }
                    u32x4 w; w.x = cvt_pk_bf16(v0[0], v0[1]); w.y = cvt_pk_bf16(v0[2], v0[3]); w.z = cvt_pk_bf16(v1[0], v1[1]); w.w = cvt_pk_bf16(v1[2], v1[3]);
                    __builtin_nontemporal_store(w, (u32x4*)(rowp + 32 * bj));
                }
            }
    }
};

struct EpiBranch {
    static constexpr bool KEEP0 = true;
    const bf16_t* U; bf16_t* Mg;
    __device__ __forceinline__ void operator()(f32x4 (&acc)[2][2][4][2], const Unit& u, int wr, int wc, int fr, int fq) const {
        const int c0 = u.pn * BM + wc * 64 + 8 * fq;
#pragma unroll
        for (int ai = 0; ai < 2; ++ai) {
            u32x4 gb[4][2], ga[4][2];
#pragma unroll
            for (int m = 0; m < 4; ++m) { const bf16_t* urow = U + (size_t)EPI_ROWS(ai, m) * LDU;
#pragma unroll
                for (int bj = 0; bj < 2; ++bj) { gb[m][bj] = *(const u32x4*)(urow + C_GB + c0 + 32 * bj); if (u.seg == 0) ga[m][bj] = *(const u32x4*)(urow + C_GA + c0 + 32 * bj); } }
            asm volatile("" ::: "memory");
#pragma unroll
            for (int m = 0; m < 4; ++m) {
                const int r = EPI_ROWS(ai, m);
#pragma unroll
                for (int bj = 0; bj < 2; ++bj) {
                    if (u.seg == 0) {
#pragma unroll
                        for (int q = 0; q < 4; ++q) {
                            const float r0 = bf_lo(ga[m][bj][q]) * fast_rcp(bf_lo(gb[m][bj][q])), r1 = bf_hi(ga[m][bj][q]) * fast_rcp(bf_hi(gb[m][bj][q]));
                            acc[ai][bj][m][q >> 1][(q & 1) * 2] *= r0; acc[ai][bj][m][q >> 1][(q & 1) * 2 + 1] *= r1;
                        }
                    } else {
                        u32x4 w;
#pragma unroll
                        for (int q = 0; q < 4; ++q) {
                            const float a0 = acc[ai][bj][m][q >> 1][(q & 1) * 2] * bf_lo(gb[m][bj][q]), a1 = acc[ai][bj][m][q >> 1][(q & 1) * 2 + 1] * bf_hi(gb[m][bj][q]);
                            w[q] = cvt_pk_bf16(a0, a1);
                        }
                        *(u32x4*)(Mg + (size_t)r * DM + c0 + 32 * bj) = w;
                    }
                }
            }
            asm volatile("" ::: "memory");
        }
    }
};

struct EpiOut {
    static constexpr bool KEEP0 = false;
    const float* xp; const float* xs; bf16_t* HP; float* SS;
    __device__ __forceinline__ void operator()(f32x4 (&acc)[2][2][4][2], const Unit& u, int wr, int wc, int fr, int fq) const {
        const int c0 = u.pn * BM + wc * 64 + 8 * fq;
        const float* xb = (u.pm < MP / BM) ? xp : (xs - (size_t)MP * DM);
#pragma unroll
        for (int ai = 0; ai < 2; ++ai) {
            f32x4 xv[4][2][2];
#pragma unroll
            for (int m = 0; m < 4; ++m) { const float* xrow = xb + (size_t)EPI_ROWS(ai, m) * DM + c0;
#pragma unroll
                for (int bj = 0; bj < 2; ++bj) { xv[m][bj][0] = __builtin_nontemporal_load((const f32x4*)(xrow + 32 * bj)); xv[m][bj][1] = __builtin_nontemporal_load((const f32x4*)(xrow + 32 * bj + 4)); } }
            asm volatile("" ::: "memory");
#pragma unroll
            for (int m = 0; m < 4; ++m) {
                const int r = EPI_ROWS(ai, m);
                float ss = 0.f;
#pragma unroll
                for (int bj = 0; bj < 2; ++bj) {
                    const f32x4 h0 = acc[ai][bj][m][0] + xv[m][bj][0], h1 = acc[ai][bj][m][1] + xv[m][bj][1];
                    ss += (h0[0] * h0[0] + h0[1] * h0[1]) + (h0[2] * h0[2] + h0[3] * h0[3]) + (h1[0] * h1[0] + h1[1] * h1[1]) + (h1[2] * h1[2] + h1[3] * h1[3]);
                    u32x4 w; w.x = cvt_pk_bf16(h0[0], h0[1]); w.y = cvt_pk_bf16(h0[2], h0[3]); w.z = cvt_pk_bf16(h1[0], h1[1]); w.w = cvt_pk_bf16(h1[2], h1[3]);
                    *(u32x4*)(HP + (size_t)r * LDHP + c0 + 32 * bj) = w;
                }
                ss += __shfl_xor(ss, 16); ss += __shfl_xor(ss, 32);
                if (fq == 0) SS[(size_t)r * 16 + u.pn * 4 + wc] = ss;
            }
            asm volatile("" ::: "memory");
        }
    }
};

struct EpiFinal {
    static constexpr bool KEEP0 = false;
    float* out; bf16_t* PLE; const float* SS; const bf16_t* HP; const LAS float* rs;
    __device__ __forceinline__ void operator()(f32x4 (&acc)[2][2][4][2], const Unit& u, int wr, int wc, int fr, int fq) const {
        const int c0 = u.pn * BM + wc * 64 + 8 * fq;
        if (u.seg == 0) {
#pragma unroll
            for (int ai = 0; ai < 2; ++ai)
#pragma unroll
                for (int m = 0; m < 4; ++m) {
                    bf16_t* prow = PLE + (size_t)EPI_ROWS(ai, m) * DM + c0;
#pragma unroll
                    for (int bj = 0; bj < 2; ++bj) {
                        const f32x4 v0 = acc[ai][bj][m][0], v1 = acc[ai][bj][m][1];
                        u32x4 w; w.x = cvt_pk_bf16(v0[0], v0[1]); w.y = cvt_pk_bf16(v0[2], v0[3]); w.z = cvt_pk_bf16(v1[0], v1[1]); w.w = cvt_pk_bf16(v1[2], v1[3]);
                        *(u32x4*)(prow + 32 * bj) = w;
                    }
                }
            return;
        }
#pragma unroll
        for (int ai = 0; ai < 2; ++ai) {
            u32x4 pw[4][2], hw[4][2]; float rstd[4];
#pragma unroll
            for (int m = 0; m < 4; ++m) { const int r = EPI_ROWS(ai, m);
#pragma unroll
                for (int bj = 0; bj < 2; ++bj) { pw[m][bj] = *(const u32x4*)(PLE + (size_t)r * DM + c0 + 32 * bj); hw[m][bj] = *(const u32x4*)(HP + (size_t)r * LDHP + c0 + 32 * bj); }
                if (rs) rstd[m] = rs[u.ti * 256 + ai * HALF + wr * 64 + m * 16 + fr];
                else { const f32x4* sp = (const f32x4*)(SS + (size_t)r * 16); const f32x4 s0 = sp[0], s1 = sp[1], s2 = sp[2], s3 = sp[3];
                    const float st = ((s0[0] + s0[1]) + (s0[2] + s0[3])) + ((s1[0] + s1[1]) + (s1[2] + s1[3])) + ((s2[0] + s2[1]) + (s2[2] + s2[3])) + ((s3[0] + s3[1]) + (s3[2] + s3[3]));
                    rstd[m] = rsqrtf(st * (1.f / DM) + EPS); } }
            asm volatile("" ::: "memory");
#pragma unroll
            for (int m = 0; m < 4; ++m) {
                float* orow = out + (size_t)EPI_ROWS(ai, m) * DM + c0;
#pragma unroll
                for (int bj = 0; bj < 2; ++bj) {
                    const f32x4 a0 = acc[ai][bj][m][0], a1 = acc[ai][bj][m][1];
                    const u32x4 p = pw[m][bj], hh = hw[m][bj];
                    f32x4 y0, y1;
                    y0[0] = bf_lo(hh[0]) + sigmoidf_(rstd[m] * a0[0]) * bf_lo(p[0]); y0[1] = bf_hi(hh[0]) + sigmoidf_(rstd[m] * a0[1]) * bf_hi(p[0]);
                    y0[2] = bf_lo(hh[1]) + sigmoidf_(rstd[m] * a0[2]) * bf_lo(p[1]); y0[3] = bf_hi(hh[1]) + sigmoidf_(rstd[m] * a0[3]) * bf_hi(p[1]);
                    y1[0] = bf_lo(hh[2]) + sigmoidf_(rstd[m] * a1[0]) * bf_lo(p[2]); y1[1] = bf_hi(hh[2]) + sigmoidf_(rstd[m] * a1[1]) * bf_hi(p[2]);
                    y1[2] = bf_lo(hh[3]) + sigmoidf_(rstd[m] * a1[2]) * bf_lo(p[3]); y1[3] = bf_hi(hh[3]) + sigmoidf_(rstd[m] * a1[3]) * bf_hi(p[3]);
                    __builtin_nontemporal_store(y0, (f32x4*)(orow + 32 * bj)); __builtin_nontemporal_store(y1, (f32x4*)(orow + 32 * bj + 4));
                }
            }
            asm volatile("" ::: "memory");
        }
    }
};
#undef EPI_ROWS
}

constexpr int RING_BYTES = 131072;
constexpr int TBL_OFF = RING_BYTES + 512;
constexpr int LDS_BYTES = 147456;
constexpr int NWAVES = 8;

__device__ __forceinline__ int crow(int r, int hi) { return (r & 3) + 8 * (r >> 2) + 4 * hi; }
typedef short v4i16_t __attribute__((ext_vector_type(4)));
__device__ __forceinline__ s16x4 vtr(const LAS unsigned char* p) { return __builtin_bit_cast(s16x4, __builtin_amdgcn_ds_read_tr16_b64_v4i16((LAS v4i16_t*)p)); }

template <bool WIN>
__device__ __forceinline__ void attn_item(bf16_t* U, const float* sink, int ci, int h, LAS unsigned char* wl, const LAS float* tbl, int lane_in) {
    constexpr int NB = WIN ? 2 : 8, NS = 2 * (NB + 1);
    int lane = lane_in; asm volatile("" : "+v"(lane));
    const int r32 = lane & 31, hi = lane >> 5;
    const bool samp = ci >= 512; const int sb = ci - 512;
    int row0, tmin;
    if (!samp) { const int c = ci & 255; row0 = (ci >> 8) * 16384 + 64 * c; tmin = (NB - c) > 0 ? (NB - c) : 0; } else { row0 = MP + 64 * sb; tmin = 0; }
    const int qcol = WIN ? (C_QA + 64 * h) : (C_QB + 64 * h);
    const int kcol = WIN ? (C_KA + 64 * (h >> 2)) : (C_KB + 64 * h);
    const int vcol = WIN ? (C_VA + 64 * (h >> 2)) : (C_VB + 64 * h);
    const int zcol = WIN ? (C_ZA + 64 * h) : (C_ZB + 64 * h);
    unsigned koff[4], voff[4];
#pragma unroll
    for (int i = 0; i < 4; ++i) { const int key = 8 * i + (lane >> 3), ch = (lane & 7) ^ ((key >> 1) & 7); koff[i] = (unsigned)(key * LDU + kcol + ch * 8); }
#pragma unroll
    for (int i = 0; i < 4; ++i) { const int dh = i >> 1, kg = i & 1; voff[i] = (unsigned)((16 * kg + (lane >> 2)) * LDU + vcol + 32 * dh + 8 * (lane & 3)); }
#define ATT_KROW(s_) ((((samp) && ((s_) >> 1) < NB) ? (CACHE_ROW0 + 512 * sb + 512 - 64 * (NB - ((s_) >> 1))) : (row0 - 64 * (NB - ((s_) >> 1)))) + 32 * ((s_) & 1))
#define ATT_DMA(s_) do { const bf16_t* kb_ = U + (size_t)ATT_KROW(s_) * LDU; LAS unsigned char* wb_ = wl + ((s_) & 1) * 8192; \
        _Pragma("unroll") for (int i_ = 0; i_ < 4; ++i_) __builtin_amdgcn_global_load_lds((const unsigned*)(kb_ + koff[i_]), (LAS unsigned*)(wb_ + i_ * 1024), 16, 0, 0); \
        _Pragma("unroll") for (int i_ = 0; i_ < 4; ++i_) __builtin_amdgcn_global_load_lds((const unsigned*)(kb_ + voff[i_]), (LAS unsigned*)(wb_ + 4096 + i_ * 1024), 16, 0, 0); } while (0)
    const int smin = 2 * tmin;
    asm volatile("s_waitcnt lgkmcnt(0)" ::: "memory");
    ATT_DMA(smin); ATT_DMA(smin + 1);
    bf16x8 qr[2][4];
#pragma unroll
    for (int qh = 0; qh < 2; ++qh)
#pragma unroll
        for (int d0 = 0; d0 < 4; ++d0) qr[qh][d0] = *(const bf16x8*)(U + (size_t)(row0 + 32 * qh + r32) * LDU + qcol + 16 * d0 + 8 * hi);
    u32x2 zr[2][2][4];
#pragma unroll
    for (int qh = 0; qh < 2; ++qh)
#pragma unroll
        for (int dh = 0; dh < 2; ++dh)
#pragma unroll
            for (int g = 0; g < 4; ++g) zr[qh][dh][g] = *(const u32x2*)(U + (size_t)(row0 + 32 * qh + r32) * LDU + 4 * hi + zcol + 32 * dh + 8 * g);
    f32x16 o[2][2];
#pragma unroll
    for (int a = 0; a < 2; ++a)
#pragma unroll
        for (int b = 0; b < 2; ++b)
#pragma unroll
            for (int r = 0; r < 16; ++r) o[a][b][r] = 0.f;
    float lrun[2];
    const float slope2 = WIN ? (LOG2E * __builtin_amdgcn_exp2f(-(float)(h + 1))) : 0.f;
    if (WIN) { lrun[0] = hi == 0 ? fast_exp2(sink[h] * LOG2E) : 0.f; lrun[1] = lrun[0]; }
    else { lrun[0] = 0.f; lrun[1] = 0.f; }
    const LAS float* th = tbl + h * 257;
    int kfo[4];
#pragma unroll
    for (int d0 = 0; d0 < 4; ++d0) kfo[d0] = r32 * 128 + (((2 * d0 + hi) ^ ((r32 >> 1) & 7)) * 16);
    const int vfo = 4096 + ((lane >> 4) & 1) * 32 + (lane & 3) * 8 + (4 * hi + ((lane & 15) >> 2)) * 64;
#pragma unroll 1
    for (int s = smin; s < NS; ++s) {
        if (s + 1 < NS) asm volatile("s_waitcnt vmcnt(8)" ::: "memory"); else asm volatile("s_waitcnt vmcnt(0)" ::: "memory");
        const LAS unsigned char* wb = wl + (s & 1) * 8192;
        f32x16 Cq[2];
#pragma unroll
        for (int qh = 0; qh < 2; ++qh) {
            f32x16 C0;
            const int iq = 32 * qh + r32;
            const float nm = -slope2 * (float)(128 + iq);
            if (WIN) {
                if (s < 4) { const float b0 = slope2 * (float)(32 * s + 4 * hi) + nm;
#pragma unroll
                    for (int r = 0; r < 16; ++r) C0[r] = __builtin_fmaf(slope2, (float)((r & 3) + 8 * (r >> 2)), b0);
                } else { const int base = 128 + iq - 32 * s - 4 * hi; const float b1 = slope2 * (float)(128 + iq) + nm;
#pragma unroll
                    for (int r = 0; r < 16; ++r) { const int cr = (r & 3) + 8 * (r >> 2); C0[r] = __builtin_fmaf(-slope2, fabsf((float)(base - cr)), b1); } }
            } else {
                if (s < 12) {
#pragma unroll
                    for (int r = 0; r < 16; ++r) C0[r] = 0.f;
                } else {
                    const int base = 512 + iq - 32 * s - 4 * hi + 128;
#pragma unroll
                    for (int r = 0; r < 16; ++r) { const int cr = (r & 3) + 8 * (r >> 2); int i0 = base - cr; i0 = i0 > 256 ? 256 : i0; C0[r] = th[i0]; }
                }
            }
            Cq[qh] = C0;
        }
        {
            bf16x8 kf[4];
#pragma unroll
            for (int d0 = 0; d0 < 4; ++d0) kf[d0] = *(const LAS bf16x8*)(wb + kfo[d0]);
            asm volatile("s_waitcnt lgkmcnt(0)" ::: "memory");
            __builtin_amdgcn_sched_barrier(0);
#pragma unroll
            for (int d0 = 0; d0 < 4; ++d0) {
                Cq[0] = __builtin_amdgcn_mfma_f32_32x32x16_bf16(kf[d0], qr[0][d0], Cq[0], 0, 0, 0);
                Cq[1] = __builtin_amdgcn_mfma_f32_32x32x16_bf16(kf[d0], qr[1][d0], Cq[1], 0, 0, 0);
            }
        }
        __builtin_amdgcn_sched_barrier(0);
        bf16x8 vf[2][2];
        { s16x4 tl[4], tu[4];
            const unsigned va = (unsigned)(uintptr_t)(wb + vfo);
            asm volatile("ds_read_b64_tr_b16 %0, %8\n\tds_read_b64_tr_b16 %1, %8 offset:512\n\tds_read_b64_tr_b16 %2, %8 offset:1024\n\tds_read_b64_tr_b16 %3, %8 offset:1536\n\t"
                         "ds_read_b64_tr_b16 %4, %8 offset:2048\n\tds_read_b64_tr_b16 %5, %8 offset:2560\n\tds_read_b64_tr_b16 %6, %8 offset:3072\n\tds_read_b64_tr_b16 %7, %8 offset:3584\n\t"
                         "s_waitcnt lgkmcnt(0)"
                         : "=&v"(tl[0]), "=&v"(tu[0]), "=&v"(tl[1]), "=&v"(tu[1]), "=&v"(tl[2]), "=&v"(tu[2]), "=&v"(tl[3]), "=&v"(tu[3]) : "v"(va) : "memory");
#pragma unroll
            for (int i = 0; i < 4; ++i) vf[i >> 1][i & 1] = (bf16x8){tl[i][0], tl[i][1], tl[i][2], tl[i][3], tu[i][0], tu[i][1], tu[i][2], tu[i][3]}; }
        if (s + 2 < NS) ATT_DMA(s + 2);
#pragma unroll
        for (int qh = 0; qh < 2; ++qh) {
            f32x16 C0 = Cq[qh];
            typedef float f32x2v __attribute__((ext_vector_type(2)));
            f32x2v ps2 = (f32x2v){0.f, 0.f};
#pragma unroll
            for (int r = 0; r < 16; r += 2) { C0[r] = fast_exp2(C0[r]); C0[r + 1] = fast_exp2(C0[r + 1]); ps2 += (f32x2v){C0[r], C0[r + 1]}; }
            lrun[qh] += ps2.x + ps2.y;
            u32x4 w0, w1;
#pragma unroll
            for (int q = 0; q < 4; ++q) { w0[q] = cvt_pk_bf16(C0[2 * q], C0[2 * q + 1]); w1[q] = cvt_pk_bf16(C0[8 + 2 * q], C0[8 + 2 * q + 1]); }
            const bf16x8 pw0 = __builtin_bit_cast(bf16x8, w0), pw1 = __builtin_bit_cast(bf16x8, w1);
#pragma unroll
            for (int dh = 0; dh < 2; ++dh) {
                o[qh][dh] = __builtin_amdgcn_mfma_f32_32x32x16_bf16(vf[dh][0], pw0, o[qh][dh], 0, 0, 0);
                o[qh][dh] = __builtin_amdgcn_mfma_f32_32x32x16_bf16(vf[dh][1], pw1, o[qh][dh], 0, 0, 0);
            }
        }
    }
#undef ATT_DMA
#undef ATT_KROW
#pragma unroll
    for (int qh = 0; qh < 2; ++qh) {
        const float lt = lrun[qh] + __shfl_xor(lrun[qh], 32);
        const float inv = 1.f / lt;
        bf16_t* rowp = U + (size_t)(row0 + 32 * qh + r32) * LDU + 8 * hi;
#pragma unroll
        for (int dh = 0; dh < 2; ++dh)
#pragma unroll
            for (int k = 0; k < 2; ++k) {
                u32x2 w[2];
#pragma unroll
                for (int e = 0; e < 2; ++e) { const int g = 2 * k + e; const u32x2 z = zr[qh][dh][g];
                    w[e].x = cvt_pk_bf16(o[qh][dh][4 * g] * inv * bf_lo(z.x), o[qh][dh][4 * g + 1] * inv * bf_hi(z.x));
                    w[e].y = cvt_pk_bf16(o[qh][dh][4 * g + 2] * inv * bf_lo(z.y), o[qh][dh][4 * g + 3] * inv * bf_hi(z.y)); }
                const auto sx = __builtin_amdgcn_permlane32_swap(w[0].x, w[1].x, false, false);
                const auto sy = __builtin_amdgcn_permlane32_swap(w[0].y, w[1].y, false, false);
                u32x4 ww; ww.x = sx[0]; ww.y = sy[0]; ww.z = sx[1]; ww.w = sy[1];
                *(u32x4*)(rowp + qcol + 32 * dh + 16 * k) = ww;
            }
    }
}

__device__ __forceinline__ unsigned f2bf(float f) { unsigned u = __builtin_bit_cast(unsigned, f); return (u + 0x7fffu + ((u >> 16) & 1u)) >> 16; }
__device__ __forceinline__ unsigned pk2(float lo, float hi) { return f2bf(lo) | (f2bf(hi) << 16); }
__device__ __forceinline__ int permrow(int n) { return (n & ~255) | ((((n >> 5) & 1) * 128) + (((n >> 6) & 3) * 32) + (n & 31)); }
__device__ __forceinline__ void p0_transpose_item(const float* W, int N, bf16_t* WT, int ldt, int col_off, const float* kscale, LAS float* scr, int item, int lane, int nscale_from = -1) {
    const int nblk = N / 32, kb = item / nblk, nb = item % nblk, k0 = 64 * kb, n0 = 32 * nb;
#pragma unroll 16
    for (int i = 0; i < 32; ++i) { const int kk = 2 * i + (lane >> 5); const float s = (kscale ? kscale[k0 + kk] : 1.f) * ((nscale_from >= 0 && n0 >= nscale_from) ? -LOG2E : 1.f); scr[kk * 33 + (lane & 31)] = __builtin_nontemporal_load(W + (size_t)(k0 + kk) * N + n0 + (lane & 31)) * s; }
    asm volatile("s_waitcnt lgkmcnt(0)" ::: "memory");
    const int c = lane & 7;
#pragma unroll
    for (int j = 0; j < 4; ++j) { const int n = (lane >> 3) + 8 * j; const LAS float* s = scr + (8 * c) * 33 + n;
        u32x4 o; o.x = pk2(s[0 * 33], s[1 * 33]); o.y = pk2(s[2 * 33], s[3 * 33]); o.z = pk2(s[4 * 33], s[5 * 33]); o.w = pk2(s[6 * 33], s[7 * 33]);
        *(u32x4*)(WT + (size_t)permrow(n0 + n) * ldt + col_off + k0 + 8 * c) = o; }
    asm volatile("s_waitcnt lgkmcnt(0)" ::: "memory");
}


#define XB_TMO      128
#define XB_XCNT(j)  (256  + 64 * (j))
#define XB_XSUB(j)  (1280 + 64 * (j))
#define XB_XGEN(j)  (2304 + 64 * (j))
#define XB_TOP      3328
#define XB_TOPGEN   3392
#define XCD_BAR_WORDS 3456
#define XB_SPIN_CAP (1u << 18)
__device__ __forceinline__ unsigned xb_ld(unsigned* p)              { return __hip_atomic_load(p, __ATOMIC_RELAXED, __HIP_MEMORY_SCOPE_AGENT); }
__device__ __forceinline__ unsigned xb_add(unsigned* p, unsigned v) { return __hip_atomic_fetch_add(p, v, __ATOMIC_RELAXED, __HIP_MEMORY_SCOPE_AGENT); }
__device__ __forceinline__ unsigned xb_xcc_id() { return (unsigned)__builtin_amdgcn_s_getreg((3 << 11) | 20) & 0xFu; }
#define XB_SPIN(cond, bar) do { unsigned _sp = 0; while (cond) { __builtin_amdgcn_s_sleep(1); \
    if ((++_sp & 255u) == 0u) { if (xb_ld(&(bar)[XB_TMO])) break; if (_sp > XB_SPIN_CAP) { atomicAdd(&(bar)[XB_TMO], 1u); break; } } } } while (0)
struct XcdBarrier { unsigned* bar; unsigned x; volatile LAS unsigned* st; };
__device__ __forceinline__ XcdBarrier xcd_barrier_post(unsigned* bar, volatile LAS unsigned* st) {
    XcdBarrier b; b.bar = bar; b.x = xb_xcc_id(); b.st = st;
    if (threadIdx.x == 0) (void)xb_add(&bar[XB_XCNT(b.x)], 1u);
    return b;
}
__device__ __forceinline__ void xcd_barrier_complete(unsigned* bar, unsigned x, unsigned& nloc, unsigned& nx) {
    const unsigned G = gridDim.x * gridDim.y * gridDim.z;
    unsigned sum, cnt, mine, sp = 0u;
    for (;;) {
        sum = 0u; cnt = 0u; mine = 0u;
#pragma unroll
        for (unsigned j = 0; j < 16; ++j) { const unsigned c = xb_ld(&bar[XB_XCNT(j)]); sum += c; cnt += (c > 0u) ? 1u : 0u; mine = (j == x) ? c : mine; }
        if (sum == G) break;
        __builtin_amdgcn_s_sleep(1);
        if ((++sp & 255u) == 0u) { if (xb_ld(&bar[XB_TMO])) break; if (sp > XB_SPIN_CAP) { atomicAdd(&bar[XB_TMO], 1u); break; } }
    }
    nloc = mine > 0u ? mine : 1u; nx = cnt > 0u ? cnt : 1u;
}
__device__ __forceinline__ void xcd_barrier(const XcdBarrier& b) {
    asm volatile("s_waitcnt vmcnt(0)" ::: "memory");
    __syncthreads();
    if (threadIdx.x == 0) {
        unsigned* bar = b.bar;
        __builtin_amdgcn_s_waitcnt(0);
        unsigned nloc = b.st[0], nx = b.st[1];
        if (nloc == 0u) { xcd_barrier_complete(bar, b.x, nloc, nx); b.st[0] = nloc; b.st[1] = nx; }
        const unsigned old = xb_add(&bar[XB_XSUB(b.x)], 1u);
        const unsigned gen = old / nloc;
        if (old + 1u == (gen + 1u) * nloc) {
            __builtin_amdgcn_fence(__ATOMIC_RELEASE, "agent");
            asm volatile("s_waitcnt vmcnt(0)" ::: "memory");
            const unsigned og = xb_add(&bar[XB_TOP], 1u);
            const unsigned tg = og / nx;
            if (og + 1u == (tg + 1u) * nx) xb_add(&bar[XB_TOPGEN], 1u);
            else XB_SPIN(xb_ld(&bar[XB_TOPGEN]) == tg, bar);
            __builtin_amdgcn_fence(__ATOMIC_ACQUIRE, "agent");
            xb_add(&bar[XB_XGEN(b.x)], 1u);
            asm volatile("s_waitcnt vmcnt(0)" ::: "memory");
        } else {
            XB_SPIN(xb_ld(&bar[XB_XGEN(b.x)]) == gen, bar);
            __builtin_amdgcn_fence(__ATOMIC_ACQUIRE, "agent");
            asm volatile("s_waitcnt vmcnt(0)" ::: "memory");
        }
    }
    __syncthreads();
}

template <int KSTEPS>
__device__ __forceinline__ void tail_partial(const bf16_t* A, int lda, const bf16_t* Bt, int ldb, int col0, LAS float* part, int lane) {
    const int fr = lane & 15, fq = lane >> 4;
    f32x4 acc[2][4];
#pragma unroll
    for (int m = 0; m < 2; ++m)
#pragma unroll
        for (int n = 0; n < 4; ++n) acc[m][n] = (f32x4){0.f, 0.f, 0.f, 0.f};
    const bf16_t* ap = A + (size_t)fr * lda + 8 * fq;
    const bf16_t* bp[4];
#pragma unroll
    for (int n = 0; n < 4; ++n) bp[n] = Bt + (size_t)permrow(col0 + 16 * n + fr) * ldb + 8 * fq;
#pragma unroll
    for (int ks = 0; ks < KSTEPS; ++ks) {
        bf16x8 a[2], b[4];
#pragma unroll
        for (int m = 0; m < 2; ++m) a[m] = *(const bf16x8*)(ap + (size_t)(16 * m) * lda + 32 * ks);
#pragma unroll
        for (int n = 0; n < 4; ++n) b[n] = *(const bf16x8*)(bp[n] + 32 * ks);
#pragma unroll
        for (int m = 0; m < 2; ++m)
#pragma unroll
            for (int n = 0; n < 4; ++n) acc[m][n] = __builtin_amdgcn_mfma_f32_16x16x32_bf16(b[n], a[m], acc[m][n], 0, 0, 0);
    }
#pragma unroll
    for (int m = 0; m < 2; ++m)
#pragma unroll
        for (int n = 0; n < 4; ++n) *(LAS f32x4*)(part + (16 * m + fr) * 64 + 16 * n + 4 * fq) = acc[m][n];
}
__device__ __forceinline__ f32x4 tail_sum(const LAS float* parts, int w0, int w1, int tid) {
    f32x4 s = (f32x4){0.f, 0.f, 0.f, 0.f};
    for (int w = w0; w < w1; ++w) s += *(const LAS f32x4*)(parts + w * 2048 + tid * 4);
    return s;
}

__device__ __forceinline__ int fresh_tid() { int t = threadIdx.x; asm volatile("" : "+v"(t)); return t; }

struct Args {
    const float* in[22]; float* out; unsigned char* ws;
};

__global__ void __launch_bounds__(NWAVES * 64, 2) fwd_megakernel(Args args) {
    extern __shared__ __attribute__((aligned(16))) unsigned char lds_raw[];
    LAS unsigned char* lds = (LAS unsigned char*)lds_raw;
    const int G = gridDim.x, bx = blockIdx.x;
    const int NGW = G * NWAVES;
#define PHASE_IDS() const int tid = fresh_tid(), lane = tid & 63, wave = __builtin_amdgcn_readfirstlane(tid >> 6), gw = bx * NWAVES + wave; (void)lane; (void)gw
    unsigned char* ws = args.ws;
    volatile LAS unsigned* bar_st = (volatile LAS unsigned*)(lds + RING_BYTES + 32);
    unsigned* bar_words = (unsigned*)ws;
    if (threadIdx.x < 2) bar_st[threadIdx.x] = 0u;
    __syncthreads();
    const XcdBarrier xbar = xcd_barrier_post(bar_words, bar_st);
    const float* x_prompt = args.in[0]; const float* x_sample = args.in[1];
    const float* ck_win = args.in[2]; const float* cv_win = args.in[3]; const float* ck_band = args.in[4]; const float* cv_band = args.in[5];
    const float* p_prompt = args.in[6]; const float* p_sample = args.in[7];
    const float* g_in = args.in[8]; const float* w_in = args.in[9]; const float* g_q_win = args.in[10]; const float* g_k_win = args.in[11];
    const float* sink_win = args.in[12]; const float* g_q_band = args.in[13]; const float* g_k_band = args.in[14]; const float* rel_bias = args.in[15];
    const float* w_o_win = args.in[16]; const float* w_o_band = args.in[17]; const float* w_out = args.in[18]; const float* g_ple = args.in[19];
    const float* w_ple_gate = args.in[20]; const float* w_ple = args.in[21];
    float* out = args.out;
    bf16_t* Win_t = (bf16_t*)(ws + WS_WIN); bf16_t* WO_t = (bf16_t*)(ws + WS_WO); bf16_t* Wout_t = (bf16_t*)(ws + WS_WOUT); bf16_t* WGP_t = (bf16_t*)(ws + WS_WGP);
    float* SS = (float*)(ws + WS_SS); bf16_t* R1 = (bf16_t*)(ws + WS_R1); bf16_t* U = (bf16_t*)(ws + WS_U); bf16_t* HP = (bf16_t*)(ws + WS_U);

    {
        PHASE_IDS();
        LAS float* scr = (LAS float*)(lds + wave * 16384);
        constexpr int I_IN = 16 * (NIN / 32);
        for (int it = gw; it < I_IN; it += NGW) p0_transpose_item(w_in, NIN, Win_t, 1024, 0, g_in, scr, it, lane, C_GA);
        if (gw == 0) { float* GT = (float*)(ws + WS_GT); GT[lane] = g_q_win[lane]; GT[64 + lane] = g_k_win[lane]; GT[128 + lane] = g_q_band[lane]; GT[192 + lane] = g_k_band[lane]; }
        for (int m0 = gw * 4; m0 < MP; m0 += NGW * 4) {
            f32x4 v[4][4]; float s2[4];
#pragma unroll
            for (int q = 0; q < 4; ++q) {
                const int m = m0 + q;
                const float* xrow = (m < MP) ? (x_prompt + (size_t)m * DM) : (x_sample + (size_t)(m - MP) * DM);
                const f32x4* xr = (const f32x4*)xrow + lane;
#pragma unroll
                for (int j = 0; j < 4; ++j) v[q][j] = __builtin_nontemporal_load(xr + 64 * j);
            }
#pragma unroll
            for (int q = 0; q < 4; ++q) { s2[q] = 0.f;
#pragma unroll
                for (int j = 0; j < 4; ++j) s2[q] += (v[q][j][0] * v[q][j][0] + v[q][j][1] * v[q][j][1]) + (v[q][j][2] * v[q][j][2] + v[q][j][3] * v[q][j][3]); }
#pragma unroll
            for (int q = 0; q < 4; ++q) {
                const float rstd = rsqrtf(wave_sum(s2[q]) * (1.f / DM) + EPS);
                u32x2* o8 = (u32x2*)(R1 + (size_t)(m0 + q) * DM) + lane;
#pragma unroll
                for (int j = 0; j < 4; ++j) { u32x2 w; w.x = pk2(v[q][j][0] * rstd, v[q][j][1] * rstd); w.y = pk2(v[q][j][2] * rstd, v[q][j][3] * rstd); o8[64 * j] = w; }
            }
        }
        for (int m = MP + gw; m < M; m += NGW) {
            const f32x4* xr = (const f32x4*)(x_sample + (size_t)(m - MP) * DM) + lane;
            f32x4 v[4]; float s2 = 0.f;
#pragma unroll
            for (int j = 0; j < 4; ++j) { v[j] = __builtin_nontemporal_load(xr + 64 * j); s2 += (v[j][0] * v[j][0] + v[j][1] * v[j][1]) + (v[j][2] * v[j][2] + v[j][3] * v[j][3]); }
            const float rstd = rsqrtf(wave_sum(s2) * (1.f / DM) + EPS);
            u32x2* o8 = (u32x2*)(R1 + (size_t)m * DM) + lane;
#pragma unroll
            for (int j = 0; j < 4; ++j) { u32x2 w; w.x = pk2(v[j][0] * rstd, v[j][1] * rstd); w.y = pk2(v[j][2] * rstd, v[j][3] * rstd); o8[64 * j] = w; }
        }
    }
    xcd_barrier(xbar);

    for (int rep = 0; rep < (PROBE_MODE == 1 ? 2 : 1); ++rep) {
    {
        pg8::Gemm g{R1, Win_t, DM, DM};
        pg8::StaticOrder S; S.init(M, NIN, G, bx, 1);
        pg8::EpiIn E{U, out, (const float*)(ws + WS_GT)};
        pg8::gemm_phase<pg8::EpiIn, 0, 0, 16, 0, 0, 16>(lds, g, S, E, fresh_tid());
        {
            PHASE_IDS();
            const int nwg_ = (M / 256) * (NIN / 256), idle0 = nwg_ % G;
            const bool use_idle = (idle0 != 0) && (G - idle0 >= 32);
            const int dw0 = use_idle ? idle0 : 0, dnw = use_idle ? (G - idle0) : G, dwb = bx - dw0;
            if (bx >= dw0) {
                LAS float* scr = (LAS float*)(lds + wave * 16384);
                constexpr int I_OW = 8 * 32, I_OUT = 16 * 32, I_G = 16 * 32, I_P = 4 * 32, NDEF = 2 * I_OW + I_OUT + I_G + I_P;
                for (int it = dwb * NWAVES + wave; it < NDEF; it += dnw * NWAVES) {
                    int r = it;
                    if (r < I_OW) { p0_transpose_item(w_o_win, DM, WO_t, 1024, 0, nullptr, scr, r, lane); continue; } r -= I_OW;
                    if (r < I_OW) { p0_transpose_item(w_o_band, DM, WO_t, 1024, 512, nullptr, scr, r, lane); continue; } r -= I_OW;
                    if (r < I_OUT) { p0_transpose_item(w_out, DM, Wout_t, 1024, 0, nullptr, scr, r, lane); continue; } r -= I_OUT;
                    if (r < I_G) { p0_transpose_item(w_ple_gate, DM, WGP_t, LDHP, 0, g_ple, scr, r, lane); continue; } r -= I_G;
                    p0_transpose_item(w_ple, DM, WGP_t, LDHP, 1024, nullptr, scr, r, lane);
                }
                const int gt = dwb * (NWAVES * 64) + tid, NGT = dnw * NWAVES * 64;
                for (int e = gt; e < 8 * 128 * 128 / 4; e += NGT) {
                    const int b = e / (128 * 32), rem = e % (128 * 32), j = rem / 32, c4 = (rem % 32) * 4;
                    const f32x4 k = __builtin_nontemporal_load((const f32x4*)(ck_win + (size_t)e * 4)), v = __builtin_nontemporal_load((const f32x4*)(cv_win + (size_t)e * 4));
                    bf16_t* urow = U + (size_t)(CACHE_ROW0 + 512 * b + 384 + j) * LDU;
                    u32x2 wk; wk.x = pk2(k[0], k[1]); wk.y = pk2(k[2], k[3]); u32x2 wv; wv.x = pk2(v[0], v[1]); wv.y = pk2(v[2], v[3]);
                    *(u32x2*)(urow + C_KA + c4) = wk; *(u32x2*)(urow + C_VA + c4) = wv;
                    if (j >= 64) { __builtin_nontemporal_store(k, (f32x4*)(out + O_KWS + ((size_t)(b * 128 + j - 64) * 128 + c4))); __builtin_nontemporal_store(v, (f32x4*)(out + O_VWS + ((size_t)(b * 128 + j - 64) * 128 + c4))); }
                }
                for (int e0 = gt; e0 < 8 * 512 * 512 / 4; e0 += 4 * NGT) {
                    f32x4 kk[4], vv[4];
#pragma unroll
                    for (int q = 0; q < 4; ++q) { const int e = e0 + q * NGT; if (e < 8 * 512 * 512 / 4) { kk[q] = __builtin_nontemporal_load((const f32x4*)(ck_band + (size_t)e * 4)); vv[q] = __builtin_nontemporal_load((const f32x4*)(cv_band + (size_t)e * 4)); } }
#pragma unroll
                    for (int q = 0; q < 4; ++q) { const int e = e0 + q * NGT; if (e < 8 * 512 * 512 / 4) {
                        const int b = e / (512 * 128), rem = e % (512 * 128), j = rem / 128, c4 = (rem % 128) * 4;
                        const f32x4 k = kk[q], v = vv[q];
                        bf16_t* urow = U + (size_t)(CACHE_ROW0 + 512 * b + j) * LDU;
                        u32x2 wk; wk.x = pk2(k[0], k[1]); wk.y = pk2(k[2], k[3]); u32x2 wv; wv.x = pk2(v[0], v[1]); wv.y = pk2(v[2], v[3]);
                        *(u32x2*)(urow + C_KB + c4) = wk; *(u32x2*)(urow + C_VB + c4) = wv;
                        if (j >= 64) { __builtin_nontemporal_store(k, (f32x4*)(out + O_KBS + ((size_t)(b * 512 + j - 64) * 512 + c4))); __builtin_nontemporal_store(v, (f32x4*)(out + O_VBS + ((size_t)(b * 512 + j - 64) * 512 + c4))); } } }
                }
            }
        }
    }
    xcd_barrier(xbar);
    }

    {
        PHASE_IDS();
        LAS float* tbl = (LAS float*)(lds + TBL_OFF);
        for (int i = tid; i < 8 * 257; i += NWAVES * 64) tbl[i] = (rel_bias[i] - rel_bias[(i / 257) * 257 + 256]) * LOG2E;
        __syncthreads();
        LAS unsigned char* wl = lds + wave * 16384;
        if (NGW == 2048) {
            const int xq = bx & 7, wx = (bx >> 3) * NWAVES + wave;
#define ATT_CHUNK(lc_) (((lc_) < 64) ? (64 * xq + (lc_)) : (512 + xq))
#pragma unroll 1
            for (int k = 0; k < 3; ++k) { const int j = wx + 256 * k; if (j < 520) attn_item<false>(U, sink_win, ATT_CHUNK(j >> 3), j & 7, wl, tbl, lane); }
            if (wx >= 8) { const int w2 = wx - 8;
#pragma unroll 1
                for (int k = 0; k < 3; ++k) { const int j = w2 + 248 * k; if (k < 2 || w2 < 24) attn_item<true>(U, sink_win, ATT_CHUNK(j >> 3), j & 7, wl, tbl, lane); } }
#undef ATT_CHUNK
        } else {
            for (int it = gw; it < 2 * 4160; it += NGW) {
                if (it < 4160) attn_item<false>(U, sink_win, it >> 3, it & 7, wl, tbl, lane);
                else { const int j = it - 4160; attn_item<true>(U, sink_win, j >> 3, j & 7, wl, tbl, lane); }
            }
        }
        __syncthreads();
    }
    xcd_barrier(xbar);

    for (int rep = 0; rep < (PROBE_MODE == 3 ? 2 : 1); ++rep) {
    {
        if (G == 256) {
            PHASE_IDS();
            const int tm = bx >> 4, tn = bx & 15, row0 = MP + 32 * tm, col0 = 64 * tn, br = wave >> 2, kw = (wave & 3) * 128;
            LAS float* parts = (LAS float*)lds;
            tail_partial<4>(U + (size_t)row0 * LDU + (br ? C_QB : C_QA) + kw, LDU, WO_t + br * 512 + kw, DM, col0, parts + wave * 2048, lane);
            __syncthreads();
            const f32x4 ca = tail_sum(parts, 0, 4, tid), cb = tail_sum(parts, 4, 8, tid);
            const int r = row0 + (tid >> 4), c = col0 + (tid & 15) * 4;
            const u32x2 ga = *(const u32x2*)(U + (size_t)r * LDU + C_GA + c), gb = *(const u32x2*)(U + (size_t)r * LDU + C_GB + c);
            u32x2 w;
            w.x = cvt_pk_bf16(bf_lo(ga.x) * ca[0] + bf_lo(gb.x) * cb[0], bf_hi(ga.x) * ca[1] + bf_hi(gb.x) * cb[1]);
            w.y = cvt_pk_bf16(bf_lo(ga.y) * ca[2] + bf_lo(gb.y) * cb[2], bf_hi(ga.y) * ca[3] + bf_hi(gb.y) * cb[3]);
            *(u32x2*)(R1 + (size_t)r * DM + c) = w;
            __syncthreads();
        }
        pg8::Gemm g{U, WO_t, LDU, DM};
        pg8::StaticOrder S; S.init(G == 256 ? MP : M, DM, G, bx, 2);
        pg8::EpiBranch E{U, R1};
        pg8::gemm_phase<pg8::EpiBranch, C_QA, 0, 8, C_QB, 512, 8>(lds, g, S, E, fresh_tid());
    }
    xcd_barrier(xbar);
    }

    for (int rep = 0; rep < (PROBE_MODE == 3 ? 2 : 1); ++rep) {
    {
        PHASE_IDS();
        for (int m0 = gw * 4; m0 < MP; m0 += NGW * 4) {
            f32x4 v[4];
#pragma unroll
            for (int q = 0; q < 4; ++q) v[q] = __builtin_nontemporal_load((const f32x4*)(p_prompt + (size_t)(m0 + q) * 256) + lane);
#pragma unroll
            for (int q = 0; q < 4; ++q) { u32x2 w; w.x = pk2(v[q][0], v[q][1]); w.y = pk2(v[q][2], v[q][3]); *((u32x2*)(HP + (size_t)(m0 + q) * LDHP + 1024) + lane) = w; }
        }
        for (int m = MP + gw; m < M; m += NGW) {
            const f32x4 v = *((const f32x4*)(p_sample + (size_t)(m - MP) * 256) + lane);
            u32x2 w; w.x = pk2(v[0], v[1]); w.y = pk2(v[2], v[3]);
            *((u32x2*)(HP + (size_t)m * LDHP + 1024) + lane) = w;
        }
        if (G == 256) {
            const int tm = bx >> 4, tn = bx & 15, row0 = MP + 32 * tm, col0 = 64 * tn, kw = wave * 128;
            LAS float* parts = (LAS float*)lds;
            tail_partial<4>(R1 + (size_t)row0 * DM + kw, DM, Wout_t + kw, DM, col0, parts + wave * 2048, lane);
            __syncthreads();
            const f32x4 cc = tail_sum(parts, 0, 8, tid);
            const int r = row0 + (tid >> 4), c = col0 + (tid & 15) * 4;
            const f32x4 h = cc + *(const f32x4*)(x_sample + (size_t)(r - MP) * DM + c);
            u32x2 w; w.x = cvt_pk_bf16(h[0], h[1]); w.y = cvt_pk_bf16(h[2], h[3]);
            *(u32x2*)(HP + (size_t)r * LDHP + c) = w;
            float ss = (h[0] * h[0] + h[1] * h[1]) + (h[2] * h[2] + h[3] * h[3]);
            ss += __shfl_xor(ss, 1); ss += __shfl_xor(ss, 2); ss += __shfl_xor(ss, 4); ss += __shfl_xor(ss, 8);
            if ((tid & 15) == 0) SS[(size_t)r * 16 + tn] = ss;
            __syncthreads();
        }
        pg8::Gemm g{R1, Wout_t, DM, DM};
        pg8::StaticOrder S; S.init(G == 256 ? MP : M, DM, G, bx, 1);
        pg8::EpiOut E{x_prompt, x_sample, HP, SS};
        pg8::gemm_phase<pg8::EpiOut, 0, 0, 16, 0, 0, 16>(lds, g, S, E, fresh_tid());
    }
    xcd_barrier(xbar);
    }

    {
        if (G == 256) {
            PHASE_IDS();
            const int tm = bx >> 4, tn = bx & 15, row0 = MP + 32 * tm, col0 = 64 * tn;
            LAS float* parts = (LAS float*)lds;
            tail_partial<1>(HP + (size_t)row0 * LDHP + 1024 + wave * 32, LDHP, WGP_t + 1024 + wave * 32, LDHP, col0, parts + wave * 2048, lane);
            __syncthreads();
            const f32x4 ple = tail_sum(parts, 0, 8, tid);
            __syncthreads();
            tail_partial<4>(HP + (size_t)row0 * LDHP + wave * 128, LDHP, WGP_t + wave * 128, LDHP, col0, parts + wave * 2048, lane);
            __syncthreads();
            const f32x4 cc = tail_sum(parts, 0, 8, tid);
            const int r = row0 + (tid >> 4), c = col0 + (tid & 15) * 4;
            const f32x4* sp = (const f32x4*)(SS + (size_t)r * 16);
            const f32x4 s0 = sp[0], s1 = sp[1], s2 = sp[2], s3 = sp[3];
            const float st = ((s0[0] + s0[1]) + (s0[2] + s0[3])) + ((s1[0] + s1[1]) + (s1[2] + s1[3])) + ((s2[0] + s2[1]) + (s2[2] + s2[3])) + ((s3[0] + s3[1]) + (s3[2] + s3[3]));
            const float rstd = rsqrtf(st * (1.f / DM) + EPS);
            const u32x2 hw = *(const u32x2*)(HP + (size_t)r * LDHP + c);
            f32x4 y;
            y[0] = bf_lo(hw.x) + sigmoidf_(rstd * cc[0]) * ple[0]; y[1] = bf_hi(hw.x) + sigmoidf_(rstd * cc[1]) * ple[1];
            y[2] = bf_lo(hw.y) + sigmoidf_(rstd * cc[2]) * ple[2]; y[3] = bf_hi(hw.y) + sigmoidf_(rstd * cc[3]) * ple[3];
            *(f32x4*)(out + (size_t)r * DM + c) = y;
            __syncthreads();
        }
        pg8::Gemm g{HP, WGP_t, LDHP, LDHP};
        pg8::StaticOrder S; S.init(G == 256 ? MP : M, DM, G, bx, 2);
        LAS float* rs = nullptr;
        if (G == 256) {
            const int t2 = fresh_tid();
            rs = (LAS float*)(lds + TBL_OFF);
            pg8::Unit uu; if (S.next(2 * (t2 >> 8), uu)) {
                const int r = uu.pm * 256 + (t2 & 255);
                const f32x4* sp = (const f32x4*)(SS + (size_t)r * 16); const f32x4 s0 = sp[0], s1 = sp[1], s2 = sp[2], s3 = sp[3];
                const float st = ((s0[0] + s0[1]) + (s0[2] + s0[3])) + ((s1[0] + s1[1]) + (s1[2] + s1[3])) + ((s2[0] + s2[1]) + (s2[2] + s2[3])) + ((s3[0] + s3[1]) + (s3[2] + s3[3]));
                rs[t2] = rsqrtf(st * (1.f / DM) + EPS); }
            __syncthreads();
        }
        pg8::EpiFinal E{out, R1, SS, HP, rs};
        pg8::gemm_phase<pg8::EpiFinal, 1024, 1024, 4, 0, 0, 16>(lds, g, S, E, fresh_tid());
    }
}

extern "C" void kernel_launch(void* const* d_in, const int* in_sizes, int n_in, void* d_out, int out_size, void* d_ws, size_t ws_size, hipStream_t stream) {
    static int grid = 0;
    if (grid == 0) {
        if (n_in != 22 || out_size != (int)O_END || ws_size < WS_END) { fprintf(stderr, "kernel_launch: unexpected sizes n_in %d out %d ws %zu (need %zu)\n", n_in, out_size, ws_size, (size_t)WS_END); grid = -1; return; }
        int dev = 0, cus = 0, per_cu = 0;
        hipGetDevice(&dev);
        hipDeviceGetAttribute(&cus, hipDeviceAttributeMultiprocessorCount, dev);
        hipFuncSetAttribute((const void*)fwd_megakernel, hipFuncAttributeMaxDynamicSharedMemorySize, LDS_BYTES);
        hipOccupancyMaxActiveBlocksPerMultiprocessor(&per_cu, (const void*)fwd_megakernel, NWAVES * 64, LDS_BYTES);
        if (per_cu < 1) { fprintf(stderr, "kernel_launch: occupancy query says %d blocks per CU\n", per_cu); per_cu = 1; }
        grid = cus;
    }
    if (grid < 0) return;
    Args a{};
    for (int i = 0; i < 22; ++i) a.in[i] = (const float*)d_in[i];
    a.out = (float*)d_out; a.ws = (unsigned char*)d_ws;
    if (hipMemsetAsync(d_ws, 0, XCD_BAR_WORDS * sizeof(unsigned), stream) != hipSuccess) { fprintf(stderr, "kernel_launch: memset of the barrier words failed\n"); return; }
    void* kargs[] = {&a};
    hipError_t e = hipLaunchCooperativeKernel((const void*)fwd_megakernel, dim3(grid), dim3(NWAVES * 64), kargs, LDS_BYTES, stream);
    if (e != hipSuccess) fprintf(stderr, "cooperative launch failed: %s (grid %d)\n", hipGetErrorString(e), grid);
}
```

```cpp
#include <hip/hip_runtime.h>
#include <hip/hip_cooperative_groups.h>
#include <cstdio>
#include <cstdint>
namespace cg = cooperative_groups;
#ifndef PROBE_MODE
#define PROBE_MODE 0
#endif

#define LAS __attribute__((address_space(3)))
#define GAS __attribute__((address_space(1)))
typedef unsigned short bf16_t;
typedef short bf16x8 __attribute__((ext_vector_type(8)));
typedef short s16x4 __attribute__((ext_vector_type(4)));
typedef float f32x4 __attribute__((ext_vector_type(4)));
typedef float f32x16 __attribute__((ext_vector_type(16)));
typedef unsigned u32x4 __attribute__((ext_vector_type(4)));
typedef unsigned u32x2 __attribute__((ext_vector_type(2)));

constexpr int MP = 32768, MS = 512, M = MP + MS;
constexpr int DM = 1024, NIN = 5376, LDU = NIN;
constexpr int CACHE_ROW0 = M;
constexpr int UROWS = M + 8 * 512;
constexpr int LDHP = 1280;
constexpr float EPS = 1e-6f;
constexpr float LOG2E = 1.4426950408889634f;
constexpr float ATT_THR = 8.f;
constexpr float C2 = 0.125f * LOG2E;
constexpr size_t O_Y = 0, O_KWP = 34078720, O_VWP = 34111488, O_KBP = 34144256, O_VBP = 34668544,
                 O_KWS = 35192832, O_VWS = 35323904, O_KBS = 35454976, O_VBS = 37552128, O_END = 39649280;
constexpr int C_QA = 0, C_KA = 512, C_VA = 640, C_ZA = 768, C_QB = 1280, C_KB = 1792, C_VB = 2304, C_ZB = 2816, C_GA = 3328, C_GB = 4352;

constexpr size_t MiB = 1u << 20;
constexpr size_t WS_GT = 1 * MiB;
constexpr size_t WS_WIN = 2 * MiB;
constexpr size_t WS_WO = 13 * MiB;
constexpr size_t WS_WOUT = 15 * MiB;
constexpr size_t WS_WGP = 17 * MiB;
constexpr size_t WS_SS = 20 * MiB;
constexpr size_t WS_R1 = 24 * MiB;
constexpr size_t WS_U = 90 * MiB;
constexpr size_t WS_END = WS_U + (size_t)UROWS * LDU * 2;
static_assert(WS_END <= 512 * MiB, "d_ws map");

typedef float f32x2_t __attribute__((ext_vector_type(2))); typedef __bf16 bf16x2_t __attribute__((ext_vector_type(2)));
__device__ __forceinline__ unsigned cvt_pk_bf16(float lo, float hi) { const f32x2_t v = {lo, hi}; const bf16x2_t b = __builtin_convertvector(v, bf16x2_t); return __builtin_bit_cast(unsigned, b); }
__device__ __forceinline__ float bf_lo(unsigned w) { return __uint_as_float(w << 16); }
__device__ __forceinline__ float bf_hi(unsigned w) { return __uint_as_float(w & 0xffff0000u); }
__device__ __forceinline__ float fast_exp2(float x) { return __builtin_amdgcn_exp2f(x); }
__device__ __forceinline__ float fast_rcp(float x) { return __builtin_amdgcn_rcpf(x); }
__device__ __forceinline__ float sigmoidf_(float x) { return fast_rcp(1.f + fast_exp2(-LOG2E * x)); }
__device__ __forceinline__ float wave_sum(float v) {
#pragma unroll
    for (int o = 1; o < 64; o <<= 1) v += __shfl_xor(v, o);
    return v;
}

namespace pg8 {
constexpr int BM = 256, BK = 64, HALF = 128, HTB = HALF * BK * 2, STAGE_BYTES = 8 * HTB, NXCD = 8, WGM = 8;
__host__ __device__ __forceinline__ int lds_byte(int r, int c) { const int st = (r >> 4) * 2 + (c >> 5), rr = r & 15, cc = c & 31, ob = rr * 64 + cc * 2; return st * 1024 + (ob ^ (((ob >> 9) & 1) << 5)); }
__host__ __device__ __forceinline__ void stage_rc(int b, int& R, int& C) { const int st = b / 1024, sb = b % 1024, swz = sb ^ (((sb >> 9) & 1) << 5); R = (st >> 1) * 16 + swz / 64; C = (st & 1) * 32 + (swz % 64) / 2; }
__host__ __device__ __forceinline__ int perm32(int rho) { const int n = rho >> 4, i = rho & 15; return 8 * (i >> 2) + 4 * n + (i & 3); }

struct Unit { int pm, pn, seg, ti; };
struct Gemm { const bf16_t* A; const bf16_t* Bt; int lda, ldb; };

struct StaticOrder {
    int nM, nN, nwg, G, c, nseg;
    __device__ void init(int M_, int N_, int G_, int c_, int nseg_) { nM = M_ / BM; nN = N_ / BM; nwg = nM * nN; G = G_; c = c_; nseg = nseg_; }
    __device__ bool next(int i, Unit& u) const {
        const int it = (nseg == 2) ? (i >> 1) : i;
        const long L = (long)it * G + c; if (L >= nwg) return false;
        int wgid = (int)L; { const int q = nwg / NXCD, r = nwg % NXCD, xcd = wgid % NXCD, off = wgid / NXCD; wgid = (xcd < r ? xcd * (q + 1) : r * (q + 1) + (xcd - r) * q) + off; }
        const int nig = WGM * nN, gid = wgid / nig, fm = gid * WGM, gsz = (nM - fm) < WGM ? (nM - fm) : WGM;
        u.pm = fm + ((wgid % nig) % gsz); u.pn = (wgid % nig) / gsz; u.seg = (nseg == 2) ? (i & 1) : 0; u.ti = it; return true;
    }
};

template <class Epi, int AC0, int BC0, int NT0, int AC1, int BC1, int NT1>
__device__ __forceinline__ void gemm_phase(LAS unsigned char* lds, const Gemm g, const StaticOrder& S, const Epi& E, int tid) {
    const int wid = __builtin_amdgcn_readfirstlane(tid >> 6), lane = tid & 63, wr = wid >> 2, wc = wid & 3, fr = lane & 15, fq = lane >> 4;
    unsigned voffA[2], voffB[2];
#pragma unroll
    for (int i = 0; i < 2; ++i) { int R, C; stage_rc(tid * 16 + i * 8192, R, C); const int Rb = (R & ~31) + perm32(R & 31);
        voffA[i] = (unsigned)(R * g.lda + C) * 2u; voffB[i] = (unsigned)(Rb * g.ldb + C) * 2u; }
    const size_t kstep = (size_t)(BK * 2);
    const size_t hstepA = (size_t)HALF * g.lda * 2, hstepB = (size_t)HALF * g.ldb * 2;
    const unsigned ldsw = (unsigned)wid * 1024u;
    const int aoff = lds_byte(wr * 64 + fr, fq * 8), boff = lds_byte(wc * 32 + fr, fq * 8);
#define PG8_SA(b, h) (((b) * 2 + (h)) * HTB)
#define PG8_SB(b, h) ((4 + (b) * 2 + (h)) * HTB)
#define PG8_STAGE(bufoff, gbase, voff) do { _Pragma("unroll") for (int _i = 0; _i < 2; ++_i) \
        __builtin_amdgcn_global_load_lds((const unsigned*)((const char*)(gbase) + (voff)[_i]), (LAS unsigned*)(lds + (bufoff) + ldsw + _i * 8192), 16, 0, 0); } while (0)
#define PG8_LDA(dst, b, h) do { _Pragma("unroll") for (int m = 0; m < 4; ++m) _Pragma("unroll") for (int k = 0; k < 2; ++k) dst[m][k] = *(const LAS bf16x8*)(lds + PG8_SA(b, h) + aoff + m * 2048 + k * 1024); } while (0)
#define PG8_LDB(dst, b, h) do { _Pragma("unroll") for (int n = 0; n < 2; ++n) _Pragma("unroll") for (int k = 0; k < 2; ++k) dst[n][k] = *(const LAS bf16x8*)(lds + PG8_SB(b, h) + boff + n * 2048 + k * 1024); } while (0)
#define PG8_MMA(ai, bj, At, Bt) do { __builtin_amdgcn_s_setprio(1); _Pragma("unroll") for (int m = 0; m < 4; ++m) _Pragma("unroll") for (int n = 0; n < 2; ++n) _Pragma("unroll") for (int k = 0; k < 2; ++k) \
        acc[ai][bj][m][n] = __builtin_amdgcn_mfma_f32_16x16x32_bf16(Bt[n][k], At[m][k], acc[ai][bj][m][n], 0, 0, 0); __builtin_amdgcn_s_setprio(0); } while (0)
#define PG8_WAIT_V(n) asm volatile("s_waitcnt vmcnt(" #n ")" ::: "memory")
#define PG8_WAIT_L(n) asm volatile("s_waitcnt lgkmcnt(" #n ")" ::: "memory")
#define PG8_BAR __builtin_amdgcn_s_barrier()
#define PG8_SCHED __builtin_amdgcn_sched_barrier(0)
#define PG8_APTR(u) ((const char*)g.A + ((size_t)(u).pm * 2 * hstepA + (size_t)(AC0 + (u).seg * (AC1 - AC0)) * 2))
#define PG8_BPTR(u) ((const char*)g.Bt + ((size_t)(u).pn * 2 * hstepB + (size_t)(BC0 + (u).seg * (BC1 - BC0)) * 2))
    Unit cur, nxt; int ui = 0;
    if (!S.next(0, cur)) return;
    f32x4 acc[2][2][4][2];
#pragma unroll
    for (int a = 0; a < 2; ++a)
#pragma unroll
        for (int b = 0; b < 2; ++b)
#pragma unroll
            for (int m = 0; m < 4; ++m)
#pragma unroll
                for (int n = 0; n < 2; ++n) acc[a][b][m][n] = (f32x4){0.f, 0.f, 0.f, 0.f};
    bf16x8 At[4][2], B0[2][2], B1[2][2];
    const char* cA = PG8_APTR(cur); const char* cB = PG8_BPTR(cur);
    PG8_STAGE(PG8_SB(0, 0), cB, voffB); PG8_STAGE(PG8_SB(0, 1), cB + hstepB, voffB); PG8_STAGE(PG8_SA(0, 0), cA, voffA); PG8_STAGE(PG8_SA(0, 1), cA + hstepA, voffA);
    if (wr == 1) PG8_BAR;
    PG8_WAIT_V(2); PG8_BAR;
    PG8_STAGE(PG8_SB(1, 0), cB + kstep, voffB); PG8_STAGE(PG8_SA(1, 0), cA + kstep, voffA); PG8_STAGE(PG8_SB(1, 1), cB + hstepB + kstep, voffB);
    PG8_WAIT_V(6); PG8_BAR;
    for (;;) {
        const bool has_next = S.next(ui + 1, nxt);
        const char* nA = has_next ? PG8_APTR(nxt) : cA; const char* nB = has_next ? PG8_BPTR(nxt) : cB;
        const int nt = NT0 + cur.seg * (NT1 - NT0);
        for (int t = 0; t < nt; t += 2) {
            const bool last = (t == nt - 2);
            const char* a1 = cA + (size_t)(t + 1) * kstep;
            const char* a2 = last ? nA : cA + (size_t)(t + 2) * kstep; const char* b2 = last ? nB : cB + (size_t)(t + 2) * kstep;
            const char* a3 = a2 + kstep; const char* b3 = b2 + kstep;
            PG8_LDB(B0, 0, 0); PG8_LDB(B1, 0, 1); PG8_SCHED; PG8_LDA(At, 0, 0); PG8_STAGE(PG8_SA(1, 1), a1 + hstepA, voffA);
            PG8_WAIT_V(8); PG8_WAIT_L(0); PG8_BAR; PG8_MMA(0, 0, At, B0); PG8_MMA(0, 1, At, B1); PG8_BAR; PG8_SCHED;
            PG8_LDA(At, 0, 1); PG8_STAGE(PG8_SB(0, 0), b2, voffB); PG8_STAGE(PG8_SB(0, 1), b2 + hstepB, voffB); PG8_STAGE(PG8_SA(0, 0), a2, voffA);
            PG8_WAIT_V(8); PG8_WAIT_L(0); PG8_BAR; PG8_MMA(1, 0, At, B0); PG8_MMA(1, 1, At, B1); PG8_BAR; PG8_SCHED;
            PG8_LDB(B0, 1, 0); PG8_LDB(B1, 1, 1); PG8_SCHED; PG8_LDA(At, 1, 0); PG8_STAGE(PG8_SA(0, 1), a2 + hstepA, voffA);
            PG8_WAIT_V(8); PG8_WAIT_L(0); PG8_BAR; PG8_MMA(0, 0, At, B0); PG8_MMA(0, 1, At, B1); PG8_BAR; PG8_SCHED;
            PG8_LDA(At, 1, 1); PG8_STAGE(PG8_SB(1, 0), b3, voffB); PG8_STAGE(PG8_SB(1, 1), b3 + hstepB, voffB); PG8_STAGE(PG8_SA(1, 0), a3, voffA);
            PG8_WAIT_V(8); PG8_WAIT_L(0); PG8_BAR; PG8_MMA(1, 0, At, B0); PG8_MMA(1, 1, At, B1); PG8_BAR; PG8_SCHED;
        }
        if (wr == 0) PG8_BAR;
        E(acc, cur, wr, wc, fr, fq);
        if (!has_next) break;
        if (!(Epi::KEEP0 && cur.seg == 0)) {
#pragma unroll
            for (int a = 0; a < 2; ++a)
#pragma unroll
                for (int b = 0; b < 2; ++b)
#pragma unroll
                    for (int m = 0; m < 4; ++m)
#pragma unroll
                        for (int n = 0; n < 2; ++n) acc[a][b][m][n] = (f32x4){0.f, 0.f, 0.f, 0.f};
        }
        cur = nxt; cA = nA; cB = nB; ++ui;
        if (wr == 1) PG8_BAR;
    }
    PG8_WAIT_V(0);
    PG8_BAR;
#undef PG8_SA
#undef PG8_SB
#undef PG8_STAGE
#undef PG8_LDA
#undef PG8_LDB
#undef PG8_MMA
#undef PG8_WAIT_V
#undef PG8_WAIT_L
#undef PG8_BAR
#undef PG8_SCHED
#undef PG8_APTR
#undef PG8_BPTR
}

#define EPI_ROWS(ai, m) (u.pm * BM + (ai) * HALF + wr * 64 + (m) * 16 + fr)

struct EpiIn {
    static constexpr bool KEEP0 = false;
    bf16_t* U; float* out; const float* GT;
    __device__ __forceinline__ void operator()(f32x4 (&acc)[2][2][4][2], const Unit& u, int wr, int wc, int fr, int fq) const {
        const int g64 = u.pn * 4 + wc;
        const bool is_q = (g64 < 8) || (g64 >= 20 && g64 < 28);
        const bool is_k = (g64 >= 8 && g64 < 10) || (g64 >= 28 && g64 < 36);
        const bool is_norm = is_q || is_k;
        const bool is_silu = (g64 >= 12 && g64 < 20) || (g64 >= 44 && g64 < 52);
        const bool is_sig = g64 >= 52;
        const float* gp = GT + 64 * (g64 < 8 ? 0 : (g64 < 10 ? 1 : (g64 < 28 ? 2 : 3)));
        const float post = is_q ? C2 : 1.f;
        const bool kv_win = (g64 >= 8 && g64 < 12), kv_band = (g64 >= 28 && g64 < 44);
        const bool tile_has_out = (u.pm == 62 || u.pm == 63 || u.pm == 126 || u.pm == 127 || u.pm >= 128);
        f32x4 gv[2][2];
#pragma unroll
        for (int bj = 0; bj < 2; ++bj)
#pragma unroll
            for (int n = 0; n < 2; ++n) gv[bj][n] = is_norm ? *(const f32x4*)(gp + 32 * bj + 8 * fq + 4 * n) : (f32x4){1.f, 1.f, 1.f, 1.f};
#pragma unroll
        for (int ai = 0; ai < 2; ++ai)
#pragma unroll
            for (int m = 0; m < 4; ++m) {
                const int r = EPI_ROWS(ai, m);
                f32x4 v[2][2];
#pragma unroll
                for (int bj = 0; bj < 2; ++bj)
#pragma unroll
                    for (int n = 0; n < 2; ++n) v[bj][n] = acc[ai][bj][m][n];
                if (is_norm) {
                    float ss = 0.f;
#pragma unroll
                    for (int bj = 0; bj < 2; ++bj)
#pragma unroll
                        for (int n = 0; n < 2; ++n) { const f32x4 x = v[bj][n]; ss += (x[0] * x[0] + x[1] * x[1]) + (x[2] * x[2] + x[3] * x[3]); }
                    ss += __shfl_xor(ss, 16); ss += __shfl_xor(ss, 32);
                    const float rs = rsqrtf(ss * (1.f / 64.f) + EPS);
#pragma unroll
                    for (int bj = 0; bj < 2; ++bj)
#pragma unroll
                        for (int n = 0; n < 2; ++n) v[bj][n] = v[bj][n] * rs * gv[bj][n];
                } else if (is_silu) {
#pragma unroll
                    for (int bj = 0; bj < 2; ++bj)
#pragma unroll
                        for (int n = 0; n < 2; ++n)
#pragma unroll
                            for (int j = 0; j < 4; ++j) v[bj][n][j] = v[bj][n][j] * sigmoidf_(v[bj][n][j]);
                } else if (is_sig) {
#pragma unroll
                    for (int bj = 0; bj < 2; ++bj)
#pragma unroll
                        for (int n = 0; n < 2; ++n)
#pragma unroll
                            for (int j = 0; j < 4; ++j) v[bj][n][j] = fast_rcp(1.f + fast_exp2(v[bj][n][j]));
                }
                if (tile_has_out && (kv_win || kv_band)) {
                    long dst = -1;
                    if (kv_win) {
                        const int hk = (g64 - 8) & 1; const bool isv = g64 >= 10;
                        if (r < MP) { const int b = r >> 14, t = r & 16383; if (t >= 16256) dst = (long)(isv ? O_VWP : O_KWP) + ((long)(b * 128 + (t - 16256)) * 2 + hk) * 64; }
                        else { const int b = (r - MP) >> 6, i = (r - MP) & 63; dst = (long)(isv ? O_VWS : O_KWS) + ((long)(b * 128 + 64 + i) * 2 + hk) * 64; }
                    } else {
                        const int h = (g64 - 28) & 7; const bool isv = g64 >= 36;
                        if (r < MP) { const int b = r >> 14, t = r & 16383; if (t >= 15872) dst = (long)(isv ? O_VBP : O_KBP) + ((long)(b * 512 + (t - 15872)) * 8 + h) * 64; }
                        else { const int b = (r - MP) >> 6, i = (r - MP) & 63; dst = (long)(isv ? O_VBS : O_KBS) + ((long)(b * 512 + 448 + i) * 8 + h) * 64; }
                    }
                    if (dst >= 0) {
#pragma unroll
                        for (int bj = 0; bj < 2; ++bj)
#pragma unroll
                            for (int n = 0; n < 2; ++n) __builtin_nontemporal_store(v[bj][n], (f32x4*)(out + dst + 32 * bj + 8 * fq + 4 * n));
                    }
                }
                bf16_t* rowp = U + (size_t)r * LDU + g64 * 64 + 8 * fq;
#pragma unroll
                for (int bj = 0; bj < 2; ++bj) {
                    f32x4 v0 = v[bj][0], v1 = v[bj][1]; if (is_q) { v0 = v0 * post; v1 = v1 * post; }
                    u32x4 w; w.x = cvt_pk_bf16(v0[0], v0[1]); w.y = cvt_pk_bf16(v0[2], v0[3]); w.z = cvt_pk_bf16(v1[0], v1[1]); w.w = cvt_pk_bf16(v1[2], v1[3]);
                    if (kv_win || kv_band) *(u32x4*)(rowp + 32 * bj) = w;
                    else __builtin_nontemporal_store(w, (u32x4*)(rowp + 32 * bj));
                }
            }
    }
};

struct EpiBranch {
    static constexpr bool KEEP0 = true;
    const bf16_t* U; bf16_t* Mg;
    __device__ __forceinline__ void operator()(f32x4 (&acc)[2][2][4][2], const Unit& u, int wr, int wc, int fr, int fq) const {
        const int c0 = u.pn * BM + wc * 64 + 8 * fq;
#pragma unroll
        for (int ai = 0; ai < 2; ++ai) {
            u32x4 gb[4][2], ga[4][2];
#pragma unroll
            for (int m = 0; m < 4; ++m) { const bf16_t* urow = U + (size_t)EPI_ROWS(ai, m) * LDU;
#pragma unroll
                for (int bj = 0; bj < 2; ++bj) { gb[m][bj] = *(const u32x4*)(urow + C_GB + c0 + 32 * bj); if (u.seg == 0) ga[m][bj] = *(const u32x4*)(urow + C_GA + c0 + 32 * bj); } }
            asm volatile("" ::: "memory");
#pragma unroll
            for (int m = 0; m < 4; ++m) {
                const int r = EPI_ROWS(ai, m);
#pragma unroll
                for (int bj = 0; bj < 2; ++bj) {
                    if (u.seg == 0) {
#pragma unroll
                        for (int q = 0; q < 4; ++q) {
                            const float r0 = bf_lo(ga[m][bj][q]) * fast_rcp(bf_lo(gb[m][bj][q])), r1 = bf_hi(ga[m][bj][q]) * fast_rcp(bf_hi(gb[m][bj][q]));
                            acc[ai][bj][m][q >> 1][(q & 1) * 2] *= r0; acc[ai][bj][m][q >> 1][(q & 1) * 2 + 1] *= r1;
                        }
                    } else {
                        u32x4 w;
#pragma unroll
                        for (int q = 0; q < 4; ++q) {
                            const float a0 = acc[ai][bj][m][q >> 1][(q & 1) * 2] * bf_lo(gb[m][bj][q]), a1 = acc[ai][bj][m][q >> 1][(q & 1) * 2 + 1] * bf_hi(gb[m][bj][q]);
                            w[q] = cvt_pk_bf16(a0, a1);
                        }
                        *(u32x4*)(Mg + (size_t)r * DM + c0 + 32 * bj) = w;
                    }
                }
            }
            asm volatile("" ::: "memory");
        }
    }
};

struct EpiOut {
    static constexpr bool KEEP0 = false;
    const float* xp; const float* xs; bf16_t* HP; float* SS;
    __device__ __forceinline__ void operator()(f32x4 (&acc)[2][2][4][2], const Unit& u, int wr, int wc, int fr, int fq) const {
        const int c0 = u.pn * BM + wc * 64 + 8 * fq;
        const float* xb = (u.pm < MP / BM) ? xp : (xs - (size_t)MP * DM);
#pragma unroll
        for (int ai = 0; ai < 2; ++ai) {
            f32x4 xv[4][2][2];
#pragma unroll
            for (int m = 0; m < 4; ++m) { const float* xrow = xb + (size_t)EPI_ROWS(ai, m) * DM + c0;
#pragma unroll
                for (int bj = 0; bj < 2; ++bj) { xv[m][bj][0] = __builtin_nontemporal_load((const f32x4*)(xrow + 32 * bj)); xv[m][bj][1] = __builtin_nontemporal_load((const f32x4*)(xrow + 32 * bj + 4)); } }
            asm volatile("" ::: "memory");
#pragma unroll
            for (int m = 0; m < 4; ++m) {
                const int r = EPI_ROWS(ai, m);
                float ss = 0.f;
#pragma unroll
                for (int bj = 0; bj < 2; ++bj) {
                    const f32x4 h0 = acc[ai][bj][m][0] + xv[m][bj][0], h1 = acc[ai][bj][m][1] + xv[m][bj][1];
                    ss += (h0[0] * h0[0] + h0[1] * h0[1]) + (h0[2] * h0[2] + h0[3] * h0[3]) + (h1[0] * h1[0] + h1[1] * h1[1]) + (h1[2] * h1[2] + h1[3] * h1[3]);
                    u32x4 w; w.x = cvt_pk_bf16(h0[0], h0[1]); w.y = cvt_pk_bf16(h0[2], h0[3]); w.z = cvt_pk_bf16(h1[0], h1[1]); w.w = cvt_pk_bf16(h1[2], h1[3]);
                    *(u32x4*)(HP + (size_t)r * LDHP + c0 + 32 * bj) = w;
                }
                ss += __shfl_xor(ss, 16); ss += __shfl_xor(ss, 32);
                if (fq == 0) SS[(size_t)r * 16 + u.pn * 4 + wc] = ss;
            }
            asm volatile("" ::: "memory");
        }
    }
};

struct EpiFinal {
    static constexpr bool KEEP0 = false;
    float* out; bf16_t* PLE; const float* SS; const bf16_t* HP; const LAS float* rs;
    __device__ __forceinline__ void operator()(f32x4 (&acc)[2][2][4][2], const Unit& u, int wr, int wc, int fr, int fq) const {
        const int c0 = u.pn * BM + wc * 64 + 8 * fq;
        if (u.seg == 0) {
#pragma unroll
            for (int ai = 0; ai < 2; ++ai)
#pragma unroll
                for (int m = 0; m < 4; ++m) {
                    bf16_t* prow = PLE + (size_t)EPI_ROWS(ai, m) * DM + c0;
#pragma unroll
                    for (int bj = 0; bj < 2; ++bj) {
                        const f32x4 v0 = acc[ai][bj][m][0], v1 = acc[ai][bj][m][1];
                        u32x4 w; w.x = cvt_pk_bf16(v0[0], v0[1]); w.y = cvt_pk_bf16(v0[2], v0[3]); w.z = cvt_pk_bf16(v1[0], v1[1]); w.w = cvt_pk_bf16(v1[2], v1[3]);
                        *(u32x4*)(prow + 32 * bj) = w;
                    }
                }
            return;
        }
#pragma unroll
        for (int ai = 0; ai < 2; ++ai) {
            u32x4 pw[4][2], hw[4][2]; float rstd[4];
#pragma unroll
            for (int m = 0; m < 4; ++m) { const int r = EPI_ROWS(ai, m);
#pragma unroll
                for (int bj = 0; bj < 2; ++bj) { pw[m][bj] = *(const u32x4*)(PLE + (size_t)r * DM + c0 + 32 * bj); hw[m][bj] = *(const u32x4*)(HP + (size_t)r * LDHP + c0 + 32 * bj); }
                if (rs) rstd[m] = rs[u.ti * 256 + ai * HALF + wr * 64 + m * 16 + fr];
                else { const f32x4* sp = (const f32x4*)(SS + (size_t)r * 16); const f32x4 s0 = sp[0], s1 = sp[1], s2 = sp[2], s3 = sp[3];
                    const float st = ((s0[0] + s0[1]) + (s0[2] + s0[3])) + ((s1[0] + s1[1]) + (s1[2] + s1[3])) + ((s2[0] + s2[1]) + (s2[2] + s2[3])) + ((s3[0] + s3[1]) + (s3[2] + s3[3]));
                    rstd[m] = rsqrtf(st * (1.f / DM) + EPS); } }
            asm volatile("" ::: "memory");
#pragma unroll
            for (int m = 0; m < 4; ++m) {
                float* orow = out + (size_t)EPI_ROWS(ai, m) * DM + c0;
#pragma unroll
                for (int bj = 0; bj < 2; ++bj) {
                    const f32x4 a0 = acc[ai][bj][m][0], a1 = acc[ai][bj][m][1];
                    const u32x4 p = pw[m][bj], hh = hw[m][bj];
                    f32x4 y0, y1;
                    y0[0] = bf_lo(hh[0]) + sigmoidf_(rstd[m] * a0[0]) * bf_lo(p[0]); y0[1] = bf_hi(hh[0]) + sigmoidf_(rstd[m] * a0[1]) * bf_hi(p[0]);
                    y0[2] = bf_lo(hh[1]) + sigmoidf_(rstd[m] * a0[2]) * bf_lo(p[1]); y0[3] = bf_hi(hh[1]) + sigmoidf_(rstd[m] * a0[3]) * bf_hi(p[1]);
                    y1[0] = bf_lo(hh[2]) + sigmoidf_(rstd[m] * a1[0]) * bf_lo(p[2]); y1[1] = bf_hi(hh[2]) + sigmoidf_(rstd[m] * a1[1]) * bf_hi(p[2]);
                    y1[2] = bf_lo(hh[3]) + sigmoidf_(rstd[m] * a1[2]) * bf_lo(p[3]); y1[3] = bf_hi(hh[3]) + sigmoidf_(rstd[m] * a1[3]) * bf_hi(p[3]);
                    __builtin_nontemporal_store(y0, (f32x4*)(orow + 32 * bj)); __builtin_nontemporal_store(y1, (f32x4*)(orow + 32 * bj + 4));
                }
            }
            asm volatile("" ::: "memory");
        }
    }
};
#undef EPI_ROWS
}

constexpr int RING_BYTES = 131072;
constexpr int TBL_OFF = RING_BYTES + 512;
constexpr int LDS_BYTES = 147456;
constexpr int NWAVES = 8;

__device__ __forceinline__ int crow(int r, int hi) { return (r & 3) + 8 * (r >> 2) + 4 * hi; }
typedef short v4i16_t __attribute__((ext_vector_type(4)));
__device__ __forceinline__ s16x4 vtr(const LAS unsigned char* p) { return __builtin_bit_cast(s16x4, __builtin_amdgcn_ds_read_tr16_b64_v4i16((LAS v4i16_t*)p)); }

template <bool WIN>
__device__ __forceinline__ void attn_item(bf16_t* U, const float* sink, int ci, int h, LAS unsigned char* wl, const LAS float* tbl, int lane_in) {
    constexpr int NB = WIN ? 2 : 8, NS = 2 * (NB + 1);
    int lane = lane_in; asm volatile("" : "+v"(lane));
    const int r32 = lane & 31, hi = lane >> 5;
    const bool samp = ci >= 512; const int sb = ci - 512;
    int row0, tmin;
    if (!samp) { const int c = ci & 255; row0 = (ci >> 8) * 16384 + 64 * c; tmin = (NB - c) > 0 ? (NB - c) : 0; } else { row0 = MP + 64 * sb; tmin = 0; }
    const int qcol = WIN ? (C_QA + 64 * h) : (C_QB + 64 * h);
    const int kcol = WIN ? (C_KA + 64 * (h >> 2)) : (C_KB + 64 * h);
    const int vcol = WIN ? (C_VA + 64 * (h >> 2)) : (C_VB + 64 * h);
    const int zcol = WIN ? (C_ZA + 64 * h) : (C_ZB + 64 * h);
    unsigned koff[4], voff[4];
#pragma unroll
    for (int i = 0; i < 4; ++i) { const int key = 8 * i + (lane >> 3), ch = (lane & 7) ^ ((key >> 1) & 7); koff[i] = (unsigned)(key * LDU + kcol + ch * 8); }
#pragma unroll
    for (int i = 0; i < 4; ++i) { const int dh = i >> 1, kg = i & 1; voff[i] = (unsigned)((16 * kg + (lane >> 2)) * LDU + vcol + 32 * dh + 8 * (lane & 3)); }
#define ATT_KROW(s_) ((((samp) && ((s_) >> 1) < NB) ? (CACHE_ROW0 + 512 * sb + 512 - 64 * (NB - ((s_) >> 1))) : (row0 - 64 * (NB - ((s_) >> 1)))) + 32 * ((s_) & 1))
#define ATT_DMA(s_) do { const bf16_t* kb_ = U + (size_t)ATT_KROW(s_) * LDU; LAS unsigned char* wb_ = wl + ((s_) & 1) * 8192; \
        _Pragma("unroll") for (int i_ = 0; i_ < 4; ++i_) __builtin_amdgcn_global_load_lds((const unsigned*)(kb_ + koff[i_]), (LAS unsigned*)(wb_ + i_ * 1024), 16, 0, 0); \
        _Pragma("unroll") for (int i_ = 0; i_ < 4; ++i_) __builtin_amdgcn_global_load_lds((const unsigned*)(kb_ + voff[i_]), (LAS unsigned*)(wb_ + 4096 + i_ * 1024), 16, 0, 0); } while (0)
    const int smin = 2 * tmin;
    asm volatile("s_waitcnt lgkmcnt(0)" ::: "memory");
    ATT_DMA(smin); ATT_DMA(smin + 1);
    bf16x8 qr[2][4];
#pragma unroll
    for (int qh = 0; qh < 2; ++qh)
#pragma unroll
        for (int d0 = 0; d0 < 4; ++d0) qr[qh][d0] = *(const bf16x8*)(U + (size_t)(row0 + 32 * qh + r32) * LDU + qcol + 16 * d0 + 8 * hi);
    u32x2 zr[2][2][4];
#pragma unroll
    for (int qh = 0; qh < 2; ++qh)
#pragma unroll
        for (int dh = 0; dh < 2; ++dh)
#pragma unroll
            for (int g = 0; g < 4; ++g) zr[qh][dh][g] = *(const u32x2*)(U + (size_t)(row0 + 32 * qh + r32) * LDU + 4 * hi + zcol + 32 * dh + 8 * g);
    f32x16 o[2][2];
#pragma unroll
    for (int a = 0; a < 2; ++a)
#pragma unroll
        for (int b = 0; b < 2; ++b)
#pragma unroll
            for (int r = 0; r < 16; ++r) o[a][b][r] = 0.f;
    float lrun[2];
    const float slope2 = WIN ? (LOG2E * __builtin_amdgcn_exp2f(-(float)(h + 1))) : 0.f;
    if (WIN) { lrun[0] = hi == 0 ? fast_exp2(sink[h] * LOG2E) : 0.f; lrun[1] = lrun[0]; }
    else { lrun[0] = 0.f; lrun[1] = 0.f; }
    const LAS float* th = tbl + h * 257;
    int kfo[4];
#pragma unroll
    for (int d0 = 0; d0 < 4; ++d0) kfo[d0] = r32 * 128 + (((2 * d0 + hi) ^ ((r32 >> 1) & 7)) * 16);
    const int vfo = 4096 + ((lane >> 4) & 1) * 32 + (lane & 3) * 8 + (4 * hi + ((lane & 15) >> 2)) * 64;
#pragma unroll 1
    for (int s = smin; s < NS; ++s) {
        if (s + 1 < NS) asm volatile("s_waitcnt vmcnt(8)" ::: "memory"); else asm volatile("s_waitcnt vmcnt(0)" ::: "memory");
        const LAS unsigned char* wb = wl + (s & 1) * 8192;
        f32x16 Cq[2];
#pragma unroll
        for (int qh = 0; qh < 2; ++qh) {
            f32x16 C0;
            const int iq = 32 * qh + r32;
            const float nm = -slope2 * (float)(128 + iq);
            if (WIN) {
                if (s < 4) { const float b0 = slope2 * (float)(32 * s + 4 * hi) + nm;
#pragma unroll
                    for (int r = 0; r < 16; ++r) C0[r] = __builtin_fmaf(slope2, (float)((r & 3) + 8 * (r >> 2)), b0);
                } else { const int base = 128 + iq - 32 * s - 4 * hi; const float b1 = slope2 * (float)(128 + iq) + nm;
#pragma unroll
                    for (int r = 0; r < 16; ++r) { const int cr = (r & 3) + 8 * (r >> 2); C0[r] = __builtin_fmaf(-slope2, fabsf((float)(base - cr)), b1); } }
            } else {
                if (s < 12) {
#pragma unroll
                    for (int r = 0; r < 16; ++r) C0[r] = 0.f;
                } else {
                    const int base = 512 + iq - 32 * s - 4 * hi + 128;
#pragma unroll
                    for (int r = 0; r < 16; ++r) { const int cr = (r & 3) + 8 * (r >> 2); int i0 = base - cr; i0 = i0 > 256 ? 256 : i0; C0[r] = th[i0]; }
                }
            }
            Cq[qh] = C0;
        }
        {
            bf16x8 kf[4];
#pragma unroll
            for (int d0 = 0; d0 < 4; ++d0) kf[d0] = *(const LAS bf16x8*)(wb + kfo[d0]);
            asm volatile("s_waitcnt lgkmcnt(0)" ::: "memory");
            __builtin_amdgcn_sched_barrier(0);
#pragma unroll
            for (int d0 = 0; d0 < 4; ++d0) {
                Cq[0] = __builtin_amdgcn_mfma_f32_32x32x16_bf16(kf[d0], qr[0][d0], Cq[0], 0, 0, 0);
                Cq[1] = __builtin_amdgcn_mfma_f32_32x32x16_bf16(kf[d0], qr[1][d0], Cq[1], 0, 0, 0);
            }
        }
        __builtin_amdgcn_sched_barrier(0);
        bf16x8 vf[2][2];
        { s16x4 tl[4], tu[4];
            const unsigned va = (unsigned)(uintptr_t)(wb + vfo);
            asm volatile("ds_read_b64_tr_b16 %0, %8\n\tds_read_b64_tr_b16 %1, %8 offset:512\n\tds_read_b64_tr_b16 %2, %8 offset:1024\n\tds_read_b64_tr_b16 %3, %8 offset:1536\n\t"
                         "ds_read_b64_tr_b16 %4, %8 offset:2048\n\tds_read_b64_tr_b16 %5, %8 offset:2560\n\tds_read_b64_tr_b16 %6, %8 offset:3072\n\tds_read_b64_tr_b16 %7, %8 offset:3584\n\t"
                         "s_waitcnt lgkmcnt(0)"
                         : "=&v"(tl[0]), "=&v"(tu[0]), "=&v"(tl[1]), "=&v"(tu[1]), "=&v"(tl[2]), "=&v"(tu[2]), "=&v"(tl[3]), "=&v"(tu[3]) : "v"(va) : "memory");
#pragma unroll
            for (int i = 0; i < 4; ++i) vf[i >> 1][i & 1] = (bf16x8){tl[i][0], tl[i][1], tl[i][2], tl[i][3], tu[i][0], tu[i][1], tu[i][2], tu[i][3]}; }
        if (s + 2 < NS) ATT_DMA(s + 2);
#pragma unroll
        for (int qh = 0; qh < 2; ++qh) {
            f32x16 C0 = Cq[qh];
            typedef float f32x2v __attribute__((ext_vector_type(2)));
            f32x2v ps2 = (f32x2v){0.f, 0.f};
#pragma unroll
            for (int r = 0; r < 16; r += 2) { C0[r] = fast_exp2(C0[r]); C0[r + 1] = fast_exp2(C0[r + 1]); ps2 += (f32x2v){C0[r], C0[r + 1]}; }
            lrun[qh] += ps2.x + ps2.y;
            u32x4 w0, w1;
#pragma unroll
            for (int q = 0; q < 4; ++q) { w0[q] = cvt_pk_bf16(C0[2 * q], C0[2 * q + 1]); w1[q] = cvt_pk_bf16(C0[8 + 2 * q], C0[8 + 2 * q + 1]); }
            const bf16x8 pw0 = __builtin_bit_cast(bf16x8, w0), pw1 = __builtin_bit_cast(bf16x8, w1);
#pragma unroll
            for (int dh = 0; dh < 2; ++dh) {
                o[qh][dh] = __builtin_amdgcn_mfma_f32_32x32x16_bf16(vf[dh][0], pw0, o[qh][dh], 0, 0, 0);
                o[qh][dh] = __builtin_amdgcn_mfma_f32_32x32x16_bf16(vf[dh][1], pw1, o[qh][dh], 0, 0, 0);
            }
        }
    }
#undef ATT_DMA
#undef ATT_KROW
#pragma unroll
    for (int qh = 0; qh < 2; ++qh) {
        const float lt = lrun[qh] + __shfl_xor(lrun[qh], 32);
        const float inv = 1.f / lt;
        bf16_t* rowp = U + (size_t)(row0 + 32 * qh + r32) * LDU + 8 * hi;
#pragma unroll
        for (int dh = 0; dh < 2; ++dh)
#pragma unroll
            for (int k = 0; k < 2; ++k) {
                u32x2 w[2];
#pragma unroll
                for (int e = 0; e < 2; ++e) { const int g = 2 * k + e; const u32x2 z = zr[qh][dh][g];
                    w[e].x = cvt_pk_bf16(o[qh][dh][4 * g] * inv * bf_lo(z.x), o[qh][dh][4 * g + 1] * inv * bf_hi(z.x));
                    w[e].y = cvt_pk_bf16(o[qh][dh][4 * g + 2] * inv * bf_lo(z.y), o[qh][dh][4 * g + 3] * inv * bf_hi(z.y)); }
                const auto sx = __builtin_amdgcn_permlane32_swap(w[0].x, w[1].x, false, false);
                const auto sy = __builtin_amdgcn_permlane32_swap(w[0].y, w[1].y, false, false);
                u32x4 ww; ww.x = sx[0]; ww.y = sy[0]; ww.z = sx[1]; ww.w = sy[1];
                *(u32x4*)(rowp + qcol + 32 * dh + 16 * k) = ww;
            }
    }
}

__device__ __forceinline__ unsigned f2bf(float f) { unsigned u = __builtin_bit_cast(unsigned, f); return (u + 0x7fffu + ((u >> 16) & 1u)) >> 16; }
__device__ __forceinline__ unsigned pk2(float lo, float hi) { return f2bf(lo) | (f2bf(hi) << 16); }
__device__ __forceinline__ int permrow(int n) { return (n & ~255) | ((((n >> 5) & 1) * 128) + (((n >> 6) & 3) * 32) + (n & 31)); }
__device__ __forceinline__ void p0_transpose_item(const float* W, int N, bf16_t* WT, int ldt, int col_off, const float* kscale, LAS float* scr, int item, int lane, int nscale_from = -1) {
    const int nblk = N / 32, kb = item / nblk, nb = item % nblk, k0 = 64 * kb, n0 = 32 * nb;
#pragma unroll 16
    for (int i = 0; i < 32; ++i) { const int kk = 2 * i + (lane >> 5); const float s = (kscale ? kscale[k0 + kk] : 1.f) * ((nscale_from >= 0 && n0 >= nscale_from) ? -LOG2E : 1.f); scr[kk * 33 + (lane & 31)] = __builtin_nontemporal_load(W + (size_t)(k0 + kk) * N + n0 + (lane & 31)) * s; }
    asm volatile("s_waitcnt lgkmcnt(0)" ::: "memory");
    const int c = lane & 7;
#pragma unroll
    for (int j = 0; j < 4; ++j) { const int n = (lane >> 3) + 8 * j; const LAS float* s = scr + (8 * c) * 33 + n;
        u32x4 o; o.x = pk2(s[0 * 33], s[1 * 33]); o.y = pk2(s[2 * 33], s[3 * 33]); o.z = pk2(s[4 * 33], s[5 * 33]); o.w = pk2(s[6 * 33], s[7 * 33]);
        *(u32x4*)(WT + (size_t)permrow(n0 + n) * ldt + col_off + k0 + 8 * c) = o; }
    asm volatile("s_waitcnt lgkmcnt(0)" ::: "memory");
}


#define XB_TMO      128
#define XB_XCNT(j)  (256  + 64 * (j))
#define XB_XSUB(j)  (1280 + 64 * (j))
#define XB_XGEN(j)  (2304 + 64 * (j))
#define XB_TOP      3328
#define XB_TOPGEN   3392
#define XCD_BAR_WORDS 3456
#define XB_SPIN_CAP (1u << 18)
__device__ __forceinline__ unsigned xb_ld(unsigned* p)              { return __hip_atomic_load(p, __ATOMIC_RELAXED, __HIP_MEMORY_SCOPE_AGENT); }
__device__ __forceinline__ unsigned xb_add(unsigned* p, unsigned v) { return __hip_atomic_fetch_add(p, v, __ATOMIC_RELAXED, __HIP_MEMORY_SCOPE_AGENT); }
__device__ __forceinline__ unsigned xb_xcc_id() { return (unsigned)__builtin_amdgcn_s_getreg((3 << 11) | 20) & 0xFu; }
#define XB_SPIN(cond, bar) do { unsigned _sp = 0; while (cond) { __builtin_amdgcn_s_sleep(1); \
    if ((++_sp & 255u) == 0u) { if (xb_ld(&(bar)[XB_TMO])) break; if (_sp > XB_SPIN_CAP) { atomicAdd(&(bar)[XB_TMO], 1u); break; } } } } while (0)
struct XcdBarrier { unsigned* bar; unsigned x; volatile LAS unsigned* st; };
__device__ __forceinline__ XcdBarrier xcd_barrier_post(unsigned* bar, volatile LAS unsigned* st) {
    XcdBarrier b; b.bar = bar; b.x = xb_xcc_id(); b.st = st;
    if (threadIdx.x == 0) (void)xb_add(&bar[XB_XCNT(b.x)], 1u);
    return b;
}
__device__ __forceinline__ void xcd_barrier_complete(unsigned* bar, unsigned x, unsigned& nloc, unsigned& nx) {
    const unsigned G = gridDim.x * gridDim.y * gridDim.z;
    unsigned sum, cnt, mine, sp = 0u;
    for (;;) {
        sum = 0u; cnt = 0u; mine = 0u;
#pragma unroll
        for (unsigned j = 0; j < 16; ++j) { const unsigned c = xb_ld(&bar[XB_XCNT(j)]); sum += c; cnt += (c > 0u) ? 1u : 0u; mine = (j == x) ? c : mine; }
        if (sum == G) break;
        __builtin_amdgcn_s_sleep(1);
        if ((++sp & 255u) == 0u) { if (xb_ld(&bar[XB_TMO])) break; if (sp > XB_SPIN_CAP) { atomicAdd(&bar[XB_TMO], 1u); break; } }
    }
    nloc = mine > 0u ? mine : 1u; nx = cnt > 0u ? cnt : 1u;
}
__device__ __forceinline__ void xcd_barrier(const XcdBarrier& b) {
    asm volatile("s_waitcnt vmcnt(0)" ::: "memory");
    __syncthreads();
    if (threadIdx.x == 0) {
        unsigned* bar = b.bar;
        __builtin_amdgcn_s_waitcnt(0);
        unsigned nloc = b.st[0], nx = b.st[1];
        if (nloc == 0u) { xcd_barrier_complete(bar, b.x, nloc, nx); b.st[0] = nloc; b.st[1] = nx; }
        const unsigned old = xb_add(&bar[XB_XSUB(b.x)], 1u);
        const unsigned gen = old / nloc;
        if (old + 1u == (gen + 1u) * nloc) {
            __builtin_amdgcn_fence(__ATOMIC_RELEASE, "agent");
            asm volatile("s_waitcnt vmcnt(0)" ::: "memory");
            const unsigned og = xb_add(&bar[XB_TOP], 1u);
            const unsigned tg = og / nx;
            if (og + 1u == (tg + 1u) * nx) xb_add(&bar[XB_TOPGEN], 1u);
            else XB_SPIN(xb_ld(&bar[XB_TOPGEN]) == tg, bar);
            __builtin_amdgcn_fence(__ATOMIC_ACQUIRE, "agent");
            xb_add(&bar[XB_XGEN(b.x)], 1u);
            asm volatile("s_waitcnt vmcnt(0)" ::: "memory");
        } else {
            XB_SPIN(xb_ld(&bar[XB_XGEN(b.x)]) == gen, bar);
            __builtin_amdgcn_fence(__ATOMIC_ACQUIRE, "agent");
            asm volatile("s_waitcnt vmcnt(0)" ::: "memory");
        }
    }
    __syncthreads();
}

template <int KSTEPS>
__device__ __forceinline__ void tail_partial(const bf16_t* A, int lda, const bf16_t* Bt, int ldb, int col0, LAS float* part, int lane) {
    const int fr = lane & 15, fq = lane >> 4;
    f32x4 acc[2][4];
#pragma unroll
    for (int m = 0; m < 2; ++m)
#pragma unroll
        for (int n = 0; n < 4; ++n) acc[m][n] = (f32x4){0.f, 0.f, 0.f, 0.f};
    const bf16_t* ap = A + (size_t)fr * lda + 8 * fq;
    const bf16_t* bp[4];
#pragma unroll
    for (int n = 0; n < 4; ++n) bp[n] = Bt + (size_t)permrow(col0 + 16 * n + fr) * ldb + 8 * fq;
#pragma unroll
    for (int ks = 0; ks < KSTEPS; ++ks) {
        bf16x8 a[2], b[4];
#pragma unroll
        for (int m = 0; m < 2; ++m) a[m] = *(const bf16x8*)(ap + (size_t)(16 * m) * lda + 32 * ks);
#pragma unroll
        for (int n = 0; n < 4; ++n) b[n] = *(const bf16x8*)(bp[n] + 32 * ks);
#pragma unroll
        for (int m = 0; m < 2; ++m)
#pragma unroll
            for (int n = 0; n < 4; ++n) acc[m][n] = __builtin_amdgcn_mfma_f32_16x16x32_bf16(b[n], a[m], acc[m][n], 0, 0, 0);
    }
#pragma unroll
    for (int m = 0; m < 2; ++m)
#pragma unroll
        for (int n = 0; n < 4; ++n) *(LAS f32x4*)(part + (16 * m + fr) * 64 + 16 * n + 4 * fq) = acc[m][n];
}
__device__ __forceinline__ f32x4 tail_sum(const LAS float* parts, int w0, int w1, int tid) {
    f32x4 s = (f32x4){0.f, 0.f, 0.f, 0.f};
    for (int w = w0; w < w1; ++w) s += *(const LAS f32x4*)(parts + w * 2048 + tid * 4);
    return s;
}

__device__ __forceinline__ int fresh_tid() { int t = threadIdx.x; asm volatile("" : "+v"(t)); return t; }

struct Args {
    const float* in[22]; float* out; unsigned char* ws;
};

__global__ void __launch_bounds__(NWAVES * 64, 2) fwd_megakernel(Args args) {
    extern __shared__ __attribute__((aligned(16))) unsigned char lds_raw[];
    LAS unsigned char* lds = (LAS unsigned char*)lds_raw;
    const int G = gridDim.x, bx = blockIdx.x;
    const int NGW = G * NWAVES;
#define PHASE_IDS() const int tid = fresh_tid(), lane = tid & 63, wave = __builtin_amdgcn_readfirstlane(tid >> 6), gw = bx * NWAVES + wave; (void)lane; (void)gw
    unsigned char* ws = args.ws;
    volatile LAS unsigned* bar_st = (volatile LAS unsigned*)(lds + RING_BYTES + 32);
    unsigned* bar_words = (unsigned*)ws;
    if (threadIdx.x < 2) bar_st[threadIdx.x] = 0u;
    __syncthreads();
    const XcdBarrier xbar = xcd_barrier_post(bar_words, bar_st);
    const float* x_prompt = args.in[0]; const float* x_sample = args.in[1];
    const float* ck_win = args.in[2]; const float* cv_win = args.in[3]; const float* ck_band = args.in[4]; const float* cv_band = args.in[5];
    const float* p_prompt = args.in[6]; const float* p_sample = args.in[7];
    const float* g_in = args.in[8]; const float* w_in = args.in[9]; const float* g_q_win = args.in[10]; const float* g_k_win = args.in[11];
    const float* sink_win = args.in[12]; const float* g_q_band = args.in[13]; const float* g_k_band = args.in[14]; const float* rel_bias = args.in[15];
    const float* w_o_win = args.in[16]; const float* w_o_band = args.in[17]; const float* w_out = args.in[18]; const float* g_ple = args.in[19];
    const float* w_ple_gate = args.in[20]; const float* w_ple = args.in[21];
    float* out = args.out;
    bf16_t* Win_t = (bf16_t*)(ws + WS_WIN); bf16_t* WO_t = (bf16_t*)(ws + WS_WO); bf16_t* Wout_t = (bf16_t*)(ws + WS_WOUT); bf16_t* WGP_t = (bf16_t*)(ws + WS_WGP);
    float* SS = (float*)(ws + WS_SS); bf16_t* R1 = (bf16_t*)(ws + WS_R1); bf16_t* U = (bf16_t*)(ws + WS_U); bf16_t* HP = (bf16_t*)(ws + WS_U);

    {
        PHASE_IDS();
        LAS float* scr = (LAS float*)(lds + wave * 16384);
        constexpr int I_IN = 16 * (NIN / 32);
        for (int it = gw; it < I_IN; it += NGW) p0_transpose_item(w_in, NIN, Win_t, 1024, 0, g_in, scr, it, lane, C_GA);
        if (gw == 0) { float* GT = (float*)(ws + WS_GT); GT[lane] = g_q_win[lane]; GT[64 + lane] = g_k_win[lane]; GT[128 + lane] = g_q_band[lane]; GT[192 + lane] = g_k_band[lane]; }
        for (int m0 = gw * 4; m0 < MP; m0 += NGW * 4) {
            f32x4 v[4][4]; float s2[4];
#pragma unroll
            for (int q = 0; q < 4; ++q) {
                const int m = m0 + q;
                const float* xrow = (m < MP) ? (x_prompt + (size_t)m * DM) : (x_sample + (size_t)(m - MP) * DM);
                const f32x4* xr = (const f32x4*)xrow + lane;
#pragma unroll
                for (int j = 0; j < 4; ++j) v[q][j] = __builtin_nontemporal_load(xr + 64 * j);
            }
#pragma unroll
            for (int q = 0; q < 4; ++q) { s2[q] = 0.f;
#pragma unroll
                for (int j = 0; j < 4; ++j) s2[q] += (v[q][j][0] * v[q][j][0] + v[q][j][1] * v[q][j][1]) + (v[q][j][2] * v[q][j][2] + v[q][j][3] * v[q][j][3]); }
#pragma unroll
            for (int q = 0; q < 4; ++q) {
                const float rstd = rsqrtf(wave_sum(s2[q]) * (1.f / DM) + EPS);
                u32x2* o8 = (u32x2*)(R1 + (size_t)(m0 + q) * DM) + lane;
#pragma unroll
                for (int j = 0; j < 4; ++j) { u32x2 w; w.x = pk2(v[q][j][0] * rstd, v[q][j][1] * rstd); w.y = pk2(v[q][j][2] * rstd, v[q][j][3] * rstd); o8[64 * j] = w; }
            }
        }
        for (int m = MP + gw; m < M; m += NGW) {
            const f32x4* xr = (const f32x4*)(x_sample + (size_t)(m - MP) * DM) + lane;
            f32x4 v[4]; float s2 = 0.f;
#pragma unroll
            for (int j = 0; j < 4; ++j) { v[j] = __builtin_nontemporal_load(xr + 64 * j); s2 += (v[j][0] * v[j][0] + v[j][1] * v[j][1]) + (v[j][2] * v[j][2] + v[j][3] * v[j][3]); }
            const float rstd = rsqrtf(wave_sum(s2) * (1.f / DM) + EPS);
            u32x2* o8 = (u32x2*)(R1 + (size_t)m * DM) + lane;
#pragma unroll
            for (int j = 0; j < 4; ++j) { u32x2 w; w.x = pk2(v[j][0] * rstd, v[j][1] * rstd); w.y = pk2(v[j][2] * rstd, v[j][3] * rstd); o8[64 * j] = w; }
        }
    }
    xcd_barrier(xbar);

    for (int rep = 0; rep < (PROBE_MODE == 1 ? 2 : 1); ++rep) {
    {
        pg8::Gemm g{R1, Win_t, DM, DM};
        pg8::StaticOrder S; S.init(M, NIN, G, bx, 1);
        pg8::EpiIn E{U, out, (const float*)(ws + WS_GT)};
        pg8::gemm_phase<pg8::EpiIn, 0, 0, 16, 0, 0, 16>(lds, g, S, E, fresh_tid());
        {
            PHASE_IDS();
            const int nwg_ = (M / 256) * (NIN / 256), idle0 = nwg_ % G;
            const bool use_idle = (idle0 != 0) && (G - idle0 >= 32);
            const int dw0 = use_idle ? idle0 : 0, dnw = use_idle ? (G - idle0) : G, dwb = bx - dw0;
            if (bx >= dw0) {
                LAS float* scr = (LAS float*)(lds + wave * 16384);
                constexpr int I_OW = 8 * 32, I_OUT = 16 * 32, I_G = 16 * 32, I_P = 4 * 32, NDEF = 2 * I_OW + I_OUT + I_G + I_P;
                for (int it = dwb * NWAVES + wave; it < NDEF; it += dnw * NWAVES) {
                    int r = it;
                    if (r < I_OW) { p0_transpose_item(w_o_win, DM, WO_t, 1024, 0, nullptr, scr, r, lane); continue; } r -= I_OW;
                    if (r < I_OW) { p0_transpose_item(w_o_band, DM, WO_t, 1024, 512, nullptr, scr, r, lane); continue; } r -= I_OW;
                    if (r < I_OUT) { p0_transpose_item(w_out, DM, Wout_t, 1024, 0, nullptr, scr, r, lane); continue; } r -= I_OUT;
                    if (r < I_G) { p0_transpose_item(w_ple_gate, DM, WGP_t, LDHP, 0, g_ple, scr, r, lane); continue; } r -= I_G;
                    p0_transpose_item(w_ple, DM, WGP_t, LDHP, 1024, nullptr, scr, r, lane);
                }
                const int gt = dwb * (NWAVES * 64) + tid, NGT = dnw * NWAVES * 64;
                for (int e = gt; e < 8 * 128 * 128 / 4; e += NGT) {
                    const int b = e / (128 * 32), rem = e % (128 * 32), j = rem / 32, c4 = (rem % 32) * 4;
                    const f32x4 k = __builtin_nontemporal_load((const f32x4*)(ck_win + (size_t)e * 4)), v = __builtin_nontemporal_load((const f32x4*)(cv_win + (size_t)e * 4));
                    bf16_t* urow = U + (size_t)(CACHE_ROW0 + 512 * b + 384 + j) * LDU;
                    u32x2 wk; wk.x = pk2(k[0], k[1]); wk.y = pk2(k[2], k[3]); u32x2 wv; wv.x = pk2(v[0], v[1]); wv.y = pk2(v[2], v[3]);
                    *(u32x2*)(urow + C_KA + c4) = wk; *(u32x2*)(urow + C_VA + c4) = wv;
                    if (j >= 64) { __builtin_nontemporal_store(k, (f32x4*)(out + O_KWS + ((size_t)(b * 128 + j - 64) * 128 + c4))); __builtin_nontemporal_store(v, (f32x4*)(out + O_VWS + ((size_t)(b * 128 + j - 64) * 128 + c4))); }
                }
                for (int e0 = gt; e0 < 8 * 512 * 512 / 4; e0 += 4 * NGT) {
                    f32x4 kk[4], vv[4];
#pragma unroll
                    for (int q = 0; q < 4; ++q) { const int e = e0 + q * NGT; if (e < 8 * 512 * 512 / 4) { kk[q] = __builtin_nontemporal_load((const f32x4*)(ck_band + (size_t)e * 4)); vv[q] = __builtin_nontemporal_load((const f32x4*)(cv_band + (size_t)e * 4)); } }
#pragma unroll
                    for (int q = 0; q < 4; ++q) { const int e = e0 + q * NGT; if (e < 8 * 512 * 512 / 4) {
                        const int b = e / (512 * 128), rem = e % (512 * 128), j = rem / 128, c4 = (rem % 128) * 4;
                        const f32x4 k = kk[q], v = vv[q];
                        bf16_t* urow = U + (size_t)(CACHE_ROW0 + 512 * b + j) * LDU;
                        u32x2 wk; wk.x = pk2(k[0], k[1]); wk.y = pk2(k[2], k[3]); u32x2 wv; wv.x = pk2(v[0], v[1]); wv.y = pk2(v[2], v[3]);
                        *(u32x2*)(urow + C_KB + c4) = wk; *(u32x2*)(urow + C_VB + c4) = wv;
                        if (j >= 64) { __builtin_nontemporal_store(k, (f32x4*)(out + O_KBS + ((size_t)(b * 512 + j - 64) * 512 + c4))); __builtin_nontemporal_store(v, (f32x4*)(out + O_VBS + ((size_t)(b * 512 + j - 64) * 512 + c4))); } } }
                }
            }
        }
    }
    xcd_barrier(xbar);
    }

    {
        PHASE_IDS();
        LAS float* tbl = (LAS float*)(lds + TBL_OFF);
        for (int i = tid; i < 8 * 257; i += NWAVES * 64) tbl[i] = (rel_bias[i] - rel_bias[(i / 257) * 257 + 256]) * LOG2E;
        __syncthreads();
        LAS unsigned char* wl = lds + wave * 16384;
        if (NGW == 2048) {
            const int xq = bx & 7, wx = (bx >> 3) * NWAVES + wave;
#define ATT_CHUNK(lc_) (((lc_) < 64) ? (64 * xq + (lc_)) : (512 + xq))
#pragma unroll 1
            for (int k = 0; k < 3; ++k) { const int j = wx + 256 * k; if (j < 520) attn_item<false>(U, sink_win, ATT_CHUNK(j >> 3), j & 7, wl, tbl, lane); }
            if (wx >= 8) { const int w2 = wx - 8;
#pragma unroll 1
                for (int k = 0; k < 3; ++k) { const int j = w2 + 248 * k; if (k < 2 || w2 < 24) attn_item<true>(U, sink_win, ATT_CHUNK(j >> 3), j & 7, wl, tbl, lane); } }
#undef ATT_CHUNK
        } else {
            for (int it = gw; it < 2 * 4160; it += NGW) {
                if (it < 4160) attn_item<false>(U, sink_win, it >> 3, it & 7, wl, tbl, lane);
                else { const int j = it - 4160; attn_item<true>(U, sink_win, j >> 3, j & 7, wl, tbl, lane); }
            }
        }
        __syncthreads();
    }
    xcd_barrier(xbar);

    for (int rep = 0; rep < (PROBE_MODE == 3 ? 2 : 1); ++rep) {
    {
        if (G == 256) {
            PHASE_IDS();
            const int tm = bx >> 4, tn = bx & 15, row0 = MP + 32 * tm, col0 = 64 * tn, br = wave >> 2, kw = (wave & 3) * 128;
            LAS float* parts = (LAS float*)lds;
            tail_partial<4>(U + (size_t)row0 * LDU + (br ? C_QB : C_QA) + kw, LDU, WO_t + br * 512 + kw, DM, col0, parts + wave * 2048, lane);
            __syncthreads();
            const f32x4 ca = tail_sum(parts, 0, 4, tid), cb = tail_sum(parts, 4, 8, tid);
            const int r = row0 + (tid >> 4), c = col0 + (tid & 15) * 4;
            const u32x2 ga = *(const u32x2*)(U + (size_t)r * LDU + C_GA + c), gb = *(const u32x2*)(U + (size_t)r * LDU + C_GB + c);
            u32x2 w;
            w.x = cvt_pk_bf16(bf_lo(ga.x) * ca[0] + bf_lo(gb.x) * cb[0], bf_hi(ga.x) * ca[1] + bf_hi(gb.x) * cb[1]);
            w.y = cvt_pk_bf16(bf_lo(ga.y) * ca[2] + bf_lo(gb.y) * cb[2], bf_hi(ga.y) * ca[3] + bf_hi(gb.y) * cb[3]);
            *(u32x2*)(R1 + (size_t)r * DM + c) = w;
            __syncthreads();
        }
        pg8::Gemm g{U, WO_t, LDU, DM};
        pg8::StaticOrder S; S.init(G == 256 ? MP : M, DM, G, bx, 2);
        pg8::EpiBranch E{U, R1};
        pg8::gemm_phase<pg8::EpiBranch, C_QA, 0, 8, C_QB, 512, 8>(lds, g, S, E, fresh_tid());
    }
    xcd_barrier(xbar);
    }

    for (int rep = 0; rep < (PROBE_MODE == 3 ? 2 : 1); ++rep) {
    {
        PHASE_IDS();
        for (int m0 = gw * 4; m0 < MP; m0 += NGW * 4) {
            f32x4 v[4];
#pragma unroll
            for (int q = 0; q < 4; ++q) v[q] = __builtin_nontemporal_load((const f32x4*)(p_prompt + (size_t)(m0 + q) * 256) + lane);
#pragma unroll
            for (int q = 0; q < 4; ++q) { u32x2 w; w.x = pk2(v[q][0], v[q][1]); w.y = pk2(v[q][2], v[q][3]); *((u32x2*)(HP + (size_t)(m0 + q) * LDHP + 1024) + lane) = w; }
        }
        for (int m = MP + gw; m < M; m += NGW) {
            const f32x4 v = *((const f32x4*)(p_sample + (size_t)(m - MP) * 256) + lane);
            u32x2 w; w.x = pk2(v[0], v[1]); w.y = pk2(v[2], v[3]);
            *((u32x2*)(HP + (size_t)m * LDHP + 1024) + lane) = w;
        }
        if (G == 256) {
            const int tm = bx >> 4, tn = bx & 15, row0 = MP + 32 * tm, col0 = 64 * tn, kw = wave * 128;
            LAS float* parts = (LAS float*)lds;
            tail_partial<4>(R1 + (size_t)row0 * DM + kw, DM, Wout_t + kw, DM, col0, parts + wave * 2048, lane);
            __syncthreads();
            const f32x4 cc = tail_sum(parts, 0, 8, tid);
            const int r = row0 + (tid >> 4), c = col0 + (tid & 15) * 4;
            const f32x4 h = cc + *(const f32x4*)(x_sample + (size_t)(r - MP) * DM + c);
            u32x2 w; w.x = cvt_pk_bf16(h[0], h[1]); w.y = cvt_pk_bf16(h[2], h[3]);
            *(u32x2*)(HP + (size_t)r * LDHP + c) = w;
            float ss = (h[0] * h[0] + h[1] * h[1]) + (h[2] * h[2] + h[3] * h[3]);
            ss += __shfl_xor(ss, 1); ss += __shfl_xor(ss, 2); ss += __shfl_xor(ss, 4); ss += __shfl_xor(ss, 8);
            if ((tid & 15) == 0) SS[(size_t)r * 16 + tn] = ss;
            __syncthreads();
        }
        pg8::Gemm g{R1, Wout_t, DM, DM};
        pg8::StaticOrder S; S.init(G == 256 ? MP : M, DM, G, bx, 1);
        pg8::EpiOut E{x_prompt, x_sample, HP, SS};
        pg8::gemm_phase<pg8::EpiOut, 0, 0, 16, 0, 0, 16>(lds, g, S, E, fresh_tid());
    }
    xcd_barrier(xbar);
    }

    {
        if (G == 256) {
            PHASE_IDS();
            const int tm = bx >> 4, tn = bx & 15, row0 = MP + 32 * tm, col0 = 64 * tn;
            LAS float* parts = (LAS float*)lds;
            tail_partial<1>(HP + (size_t)row0 * LDHP + 1024 + wave * 32, LDHP, WGP_t + 1024 + wave * 32, LDHP, col0, parts + wave * 2048, lane);
            __syncthreads();
            const f32x4 ple = tail_sum(parts, 0, 8, tid);
            __syncthreads();
            tail_partial<4>(HP + (size_t)row0 * LDHP + wave * 128, LDHP, WGP_t + wave * 128, LDHP, col0, parts + wave * 2048, lane);
            __syncthreads();
            const f32x4 cc = tail_sum(parts, 0, 8, tid);
            const int r = row0 + (tid >> 4), c = col0 + (tid & 15) * 4;
            const f32x4* sp = (const f32x4*)(SS + (size_t)r * 16);
            const f32x4 s0 = sp[0], s1 = sp[1], s2 = sp[2], s3 = sp[3];
            const float st = ((s0[0] + s0[1]) + (s0[2] + s0[3])) + ((s1[0] + s1[1]) + (s1[2] + s1[3])) + ((s2[0] + s2[1]) + (s2[2] + s2[3])) + ((s3[0] + s3[1]) + (s3[2] + s3[3]));
            const float rstd = rsqrtf(st * (1.f / DM) + EPS);
            const u32x2 hw = *(const u32x2*)(HP + (size_t)r * LDHP + c);
            f32x4 y;
            y[0] = bf_lo(hw.x) + sigmoidf_(rstd * cc[0]) * ple[0]; y[1] = bf_hi(hw.x) + sigmoidf_(rstd * cc[1]) * ple[1];
            y[2] = bf_lo(hw.y) + sigmoidf_(rstd * cc[2]) * ple[2]; y[3] = bf_hi(hw.y) + sigmoidf_(rstd * cc[3]) * ple[3];
            *(f32x4*)(out + (size_t)r * DM + c) = y;
            __syncthreads();
        }
        pg8::Gemm g{HP, WGP_t, LDHP, LDHP};
        pg8::StaticOrder S; S.init(G == 256 ? MP : M, DM, G, bx, 2);
        LAS float* rs = nullptr;
        if (G == 256) {
            const int t2 = fresh_tid();
            rs = (LAS float*)(lds + TBL_OFF);
            pg8::Unit uu; if (S.next(2 * (t2 >> 8), uu)) {
                const int r = uu.pm * 256 + (t2 & 255);
                const f32x4* sp = (const f32x4*)(SS + (size_t)r * 16); const f32x4 s0 = sp[0], s1 = sp[1], s2 = sp[2], s3 = sp[3];
                const float st = ((s0[0] + s0[1]) + (s0[2] + s0[3])) + ((s1[0] + s1[1]) + (s1[2] + s1[3])) + ((s2[0] + s2[1]) + (s2[2] + s2[3])) + ((s3[0] + s3[1]) + (s3[2] + s3[3]));
                rs[t2] = rsqrtf(st * (1.f / DM) + EPS); }
            __syncthreads();
        }
        pg8::EpiFinal E{out, R1, SS, HP, rs};
        pg8::gemm_phase<pg8::EpiFinal, 1024, 1024, 4, 0, 0, 16>(lds, g, S, E, fresh_tid());
    }
}

extern "C" void kernel_launch(void* const* d_in, const int* in_sizes, int n_in, void* d_out, int out_size, void* d_ws, size_t ws_size, hipStream_t stream) {
    static int grid = 0;
    if (grid == 0) {
        if (n_in != 22 || out_size != (int)O_END || ws_size < WS_END) { fprintf(stderr, "kernel_launch: unexpected sizes n_in %d out %d ws %zu (need %zu)\n", n_in, out_size, ws_size, (size_t)WS_END); grid = -1; return; }
        int dev = 0, cus = 0, per_cu = 0;
        hipGetDevice(&dev);
        hipDeviceGetAttribute(&cus, hipDeviceAttributeMultiprocessorCount, dev);
        hipFuncSetAttribute((const void*)fwd_megakernel, hipFuncAttributeMaxDynamicSharedMemorySize, LDS_BYTES);
        hipOccupancyMaxActiveBlocksPerMultiprocessor(&per_cu, (const void*)fwd_megakernel, NWAVES * 64, LDS_BYTES);
        if (per_cu < 1) { fprintf(stderr, "kernel_launch: occupancy query says %d blocks per CU\n", per_cu); per_cu = 1; }
        grid = cus;
    }
    if (grid < 0) return;
    Args a{};
    for (int i = 0; i < 22; ++i) a.in[i] = (const float*)d_in[i];
    a.out = (float*)d_out; a.ws = (unsigned char*)d_ws;
    if (hipMemsetAsync(d_ws, 0, XCD_BAR_WORDS * sizeof(unsigned), stream) != hipSuccess) { fprintf(stderr, "kernel_launch: memset of the barrier words failed\n"); return; }
    void* kargs[] = {&a};
    hipError_t e = hipLaunchCooperativeKernel((const void*)fwd_megakernel, dim3(grid), dim3(NWAVES * 64), kargs, LDS_BYTES, stream);
    if (e != hipSuccess) fprintf(stderr, "cooperative launch failed: %s (grid %d)\n", hipGetErrorString(e), grid);
}
```
